# Optimizing an MI355X kernel written in HIP

```python
import math
import jax, jax.numpy as jnp
from jax import lax
import numpy as np

D_MODEL = 1024
BATCH = 16
SEQ = 256
DEPTH = 2
DEC_BATCH = 8
DEC_SEQ = 4096
PAST_LEN = 512

GRID_W = 64
N_EVEN = (DEPTH + 1) // 2
N_ODD = DEPTH // 2
CHUNK = 128
Q_BLOCK = 128
EPS = 1e-6
ROPE_BASE = 10000.0
A_HEADS = 4
A_QK = 64
A_V = 2 * A_QK
A_QKW = A_HEADS * 2 * A_QK
A_WIDTH = A_HEADS * A_V
N_FREQ = A_QK // 4
B_GROUPS = 4
B_CH = 128
B_WIDTH = B_GROUPS * B_CH
MIX0 = A_WIDTH + B_WIDTH
IN0 = 2 * A_QKW + A_WIDTH + 2 * B_WIDTH
C_HEADS = 4
C_INNER = D_MODEL
C_HD = C_INNER // C_HEADS
IN1 = 2 * C_INNER + 4 * C_HEADS
D_FF = ((8 * D_MODEL // 3 + 127) // 128) * 128
N_MOD = 6

kernel_name = 'hybrid_diffusion_diffattn_gmlp_mlstm_step'


def _rmsnorm(x, w):
    xf = x.astype(jnp.float32)
    y = xf * lax.rsqrt(jnp.mean(xf * xf, axis=-1, keepdims=True) + EPS)
    return (y * w.astype(jnp.float32)).astype(x.dtype)


def _ada(cond, w, b):
    mod = jax.nn.silu(cond) @ w + b
    return jnp.split(mod[..., None, :], N_MOD, axis=-1)


def _modulate(x, w, shift, scale):
    return _rmsnorm(x, w) * (1 + scale) + shift


def _dwconv3(x, w, b):
    xp = jnp.pad(x, ((0, 0), (1, 1), (0, 0)))
    return xp[:, :-2] * w[0] + xp[:, 1:-1] * w[1] + xp[:, 2:] * w[2] + b


def _axial_rope_tables(length):
    n_rows = length // GRID_W
    rows = jnp.repeat(jnp.arange(n_rows, dtype=jnp.float32), GRID_W)
    cols = jnp.tile(jnp.arange(GRID_W, dtype=jnp.float32), n_rows)
    inv = ROPE_BASE ** (-jnp.arange(N_FREQ, dtype=jnp.float32) / N_FREQ)
    ang = jnp.stack([rows[:, None] * inv, cols[:, None] * inv], axis=1)
    return jnp.cos(ang), jnp.sin(ang)


def _rope(x, cos, sin):
    xs = x.reshape(*x.shape[:-1], 2, 2, N_FREQ)
    x1, x2 = xs[..., 0, :], xs[..., 1, :]
    c = cos.reshape(cos.shape[0], 1, 1, 2, N_FREQ).astype(x.dtype)
    s = sin.reshape(sin.shape[0], 1, 1, 2, N_FREQ).astype(x.dtype)
    out = jnp.stack([x1 * c - x2 * s, x2 * c + x1 * s], axis=-2)
    return out.reshape(x.shape)


def _diff_attention(q, k, v, lam):
    Bn, Lq = q.shape[:2]
    nb = Lq // Q_BLOCK
    qb = jnp.moveaxis(q.reshape(Bn, nb, Q_BLOCK, *q.shape[2:]), 1, 0)
    scale = A_QK ** -0.5

    def block(qi):
        s = jnp.einsum('bqhmd,bkhmd->mbhqk', qi, k).astype(jnp.float32) * scale
        p = jax.nn.softmax(s, axis=-1)
        w = (p[0] - lam * p[1]).astype(v.dtype)
        return jnp.einsum('bhqk,bkhe->bqhe', w, v)

    out = lax.map(block, qb)
    return jnp.moveaxis(out, 0, 1).reshape(Bn, Lq, A_HEADS, A_V)


def _chunk_gmlp(u, v, norm_w, w_s, b_s):
    Bn, L, _ = u.shape
    vc = _rmsnorm(v, norm_w).reshape(Bn, L // CHUNK, CHUNK, B_GROUPS, B_CH)
    s = jnp.einsum('gts,bnsgc->bntgc', w_s, vc) + b_s.T[:, :, None]
    return u * s.reshape(Bn, L, B_WIDTH)


def _even_mixer(h, layer_idx, w_in, lq1, lk1, lq2, lk2, subln_w, gn_w, w_s, b_s, w_out,
                rope=None, ctx_k=None, ctx_v=None):
    Bn, L, _ = h.shape
    z = h @ w_in
    q, k, v, gu, gv = jnp.split(z, [A_QKW, 2 * A_QKW, 2 * A_QKW + A_WIDTH,
                                    2 * A_QKW + A_WIDTH + B_WIDTH], axis=-1)
    q = q.reshape(Bn, L, A_HEADS, 2, A_QK)
    k = k.reshape(Bn, L, A_HEADS, 2, A_QK)
    v = v.reshape(Bn, L, A_HEADS, A_V)
    k_own, v_own = k, v
    if rope is not None:
        q = _rope(q, *rope)
        k = jnp.concatenate([ctx_k.reshape(Bn, -1, A_HEADS, 2, A_QK).astype(k.dtype),
                             _rope(k, *rope)], axis=1)
        v = jnp.concatenate([ctx_v.astype(v.dtype), v], axis=1)
    lam_init = 0.8 - 0.6 * math.exp(-0.3 * layer_idx)
    f32 = jnp.float32
    lam = (jnp.exp(jnp.sum(lq1.astype(f32) * lk1.astype(f32)))
           - jnp.exp(jnp.sum(lq2.astype(f32) * lk2.astype(f32))) + lam_init)
    a = _diff_attention(q, k, v, lam)
    a = (_rmsnorm(a, subln_w) * (1 - lam_init)).reshape(Bn, L, A_WIDTH)
    g = _chunk_gmlp(jax.nn.gelu(gu), jax.nn.gelu(gv), gn_w, w_s, b_s)
    y = jnp.concatenate([a, g], axis=-1) @ w_out
    return y, k_own.reshape(Bn, L, A_HEADS, 2 * A_QK), v_own


def _mlstm_scan(q, k, v, li, lf, C0, n0, m0):
    Bn, H, L, _ = q.shape
    nc = L // CHUNK

    def chunks(t):
        return jnp.moveaxis(t.reshape(Bn, H, nc, CHUNK, *t.shape[3:]), 2, 0)

    lower = jnp.tril(jnp.ones((CHUNK, CHUNK), dtype=bool))

    def step(carry, xs):
        C, n, m = carry
        qc, kc, vc, ic, fc = xs
        b = jnp.cumsum(fc, axis=-1)
        a_inter = b + m[..., None]
        d = jnp.where(lower, b[..., :, None] - b[..., None, :] + ic[..., None, :], -jnp.inf)
        m_t = jnp.maximum(a_inter, jnp.max(d, axis=-1))
        w_inter = jnp.exp(a_inter - m_t)
        s = jnp.einsum('bhtd,bhsd->bhts', qc, kc) * jnp.exp(d - m_t[..., None])
        num = (jnp.einsum('bhts,bhse->bhte', s, vc)
               + w_inter[..., None] * jnp.einsum('bhtd,bhde->bhte', qc, C))
        den = jnp.sum(s, axis=-1) + w_inter * jnp.einsum('bhtd,bhd->bht', qc, n)
        h = num / jnp.maximum(jnp.abs(den), jnp.exp(-m_t))[..., None]
        b_end = b[..., -1]
        g = b_end[..., None] - b + ic
        m_new = jnp.maximum(b_end + m, jnp.max(g, axis=-1))
        decay = jnp.exp(b_end + m - m_new)
        ws = jnp.exp(g - m_new[..., None])
        C_new = decay[..., None, None] * C + jnp.einsum('bhs,bhsd,bhse->bhde', ws, kc, vc)
        n_new = decay[..., None] * n + jnp.einsum('bhs,bhsd->bhd', ws, kc)
        return (C_new, n_new, m_new), h

    (C, n, m), hs = lax.scan(step, (C0, n0, m0),
                             (chunks(q), chunks(k), chunks(v), chunks(li), chunks(lf)))
    return jnp.moveaxis(hs, 0, 2).reshape(Bn, H, L, -1), C, n, m


def _mlstm_bidir(q, k, v, gates, init_f, init_b):
    rev = lambda t: jnp.flip(t, axis=2)
    h_f, C_f, n_f, m_f = _mlstm_scan(q, k, v, gates[0], jax.nn.log_sigmoid(gates[1]), *init_f)
    h_b, C_b, n_b, m_b = _mlstm_scan(rev(q), rev(k), rev(v), rev(gates[2]),
                                     rev(jax.nn.log_sigmoid(gates[3])), *init_b)
    return h_f + rev(h_b), (C_f, n_f, m_f), (C_b, n_b, m_b)


def _odd_mixer(h, init_f, init_b, w_in, b_g, cw, cb, wq, wk, wv, hn_w, skip, w_out):
    Bn, L, _ = h.shape
    f32 = jnp.float32
    z = h @ w_in
    xm, og, g = jnp.split(z, [C_INNER, 2 * C_INNER], axis=-1)
    xc = jax.nn.silu(_dwconv3(xm, cw, cb))
    heads = lambda t: t.reshape(Bn, L, C_HEADS, C_HD)
    q = jnp.einsum('blhd,hde->bhle', heads(xc), wq).astype(f32)
    k = (jnp.einsum('blhd,hde->bhle', heads(xc), wk) * C_HD ** -0.5).astype(f32)
    v = jnp.einsum('blhd,hde->bhle', heads(xm), wv).astype(f32)
    gates = (g + b_g).astype(f32).reshape(Bn, L, 4, C_HEADS).transpose(2, 0, 3, 1)
    hsum, st_f, st_b = _mlstm_bidir(q, k, v, gates, init_f, init_b)
    hsum = hsum.transpose(0, 2, 1, 3).astype(h.dtype)
    hn = _rmsnorm(hsum, hn_w.reshape(C_HEADS, C_HD)).reshape(Bn, L, C_INNER)
    y = jax.nn.sigmoid(og) * (hn + skip * xc)
    return y @ w_out, st_f, st_b


def _conv_ffn(h, w_up, cw, cb, w_down):
    a, g = jnp.split(h @ w_up, 2, axis=-1)
    return (jax.nn.gelu(_dwconv3(a, cw, cb)) * g) @ w_down


def setup_inputs(seed: int = 0) -> dict:
    key = jax.random.key(seed)
    ks = jax.random.split(key, 48)
    nrm = lambda k, shape, scale: scale * jax.random.normal(k, shape, jnp.float32)
    gain = lambda k, shape: 1.0 + 0.05 * jax.random.normal(k, shape, jnp.float32)
    d = D_MODEL
    f_bias = jnp.broadcast_to(jnp.linspace(3.0, 6.0, C_HEADS, dtype=jnp.float32), (N_ODD, C_HEADS))
    b_gates = jnp.concatenate([
        nrm(ks[20], (N_ODD, C_HEADS), 0.1),
        f_bias + nrm(ks[21], (N_ODD, C_HEADS), 0.01),
        nrm(ks[22], (N_ODD, C_HEADS), 0.1),
        f_bias + nrm(ks[23], (N_ODD, C_HEADS), 0.01)], axis=-1)
    return {
        'x_prompt': nrm(ks[0], (BATCH, SEQ, d), 1.0),
        'x_sample': nrm(ks[1], (DEC_BATCH, DEC_SEQ, d), 1.0),
        'cache_k': nrm(ks[2], (DEC_BATCH, N_EVEN, PAST_LEN, A_HEADS, 2 * A_QK), 1.0),
        'cache_v': nrm(ks[3], (DEC_BATCH, N_EVEN, PAST_LEN, A_HEADS, A_V), 1.0),
        'state_C': nrm(ks[4], (DEC_BATCH, N_ODD, 2, C_HEADS, C_HD, C_HD), 0.05),
        'state_n': nrm(ks[5], (DEC_BATCH, N_ODD, 2, C_HEADS, C_HD), 0.05),
        'state_m': nrm(ks[6], (DEC_BATCH, N_ODD, 2, C_HEADS), 0.5),
        'c': nrm(ks[7], (DEC_BATCH, d), 1.0),
        'c_ctx': nrm(ks[8], (d,), 1.0),
        'w_mod': nrm(ks[9], (DEPTH, d, N_MOD * d), 0.5 * d ** -0.5),
        'b_mod': nrm(ks[10], (DEPTH, N_MOD * d), 0.02),
        'norm1_w': gain(ks[11], (DEPTH, d)),
        'norm2_w': gain(ks[12], (DEPTH, d)),
        'w_in0': nrm(ks[13], (N_EVEN, d, IN0), d ** -0.5),
        'lam_q1': nrm(ks[14], (N_EVEN, A_QK), 0.1),
        'lam_k1': nrm(ks[15], (N_EVEN, A_QK), 0.1),
        'lam_q2': nrm(ks[16], (N_EVEN, A_QK), 0.1),
        'lam_k2': nrm(ks[17], (N_EVEN, A_QK), 0.1),
        'subln_w': gain(ks[18], (N_EVEN, A_V)),
        'gate_norm_w': gain(ks[19], (N_EVEN, B_WIDTH)),
        'w_spatial': nrm(ks[24], (N_EVEN, B_GROUPS, CHUNK, CHUNK), CHUNK ** -0.5),
        'b_spatial': 1.0 + nrm(ks[25], (N_EVEN, B_GROUPS, CHUNK), 0.02),
        'w_out0': nrm(ks[26], (N_EVEN, MIX0, d), MIX0 ** -0.5),
        'w_in1': nrm(ks[27], (N_ODD, d, IN1), d ** -0.5),
        'b_gates': b_gates,
        'mconv_w': nrm(ks[28], (N_ODD, 3, C_INNER), 0.5),
        'mconv_b': nrm(ks[29], (N_ODD, C_INNER), 0.02),
        'w_q': nrm(ks[30], (N_ODD, C_HEADS, C_HD, C_HD), C_HD ** -0.5),
        'w_k': nrm(ks[31], (N_ODD, C_HEADS, C_HD, C_HD), C_HD ** -0.5),
        'w_v': nrm(ks[32], (N_ODD, C_HEADS, C_HD, C_HD), C_HD ** -0.5),
        'head_norm_w': gain(ks[33], (N_ODD, C_INNER)),
        'skip_w': gain(ks[34], (N_ODD, C_INNER)),
        'w_out1': nrm(ks[35], (N_ODD, C_INNER, d), C_INNER ** -0.5),
        'w_up': nrm(ks[36], (DEPTH, d, 2 * D_FF), d ** -0.5),
        'fconv_w': nrm(ks[37], (DEPTH, 3, D_FF), 0.5),
        'fconv_b': nrm(ks[38], (DEPTH, D_FF), 0.02),
        'w_down': nrm(ks[39], (DEPTH, D_FF, d), D_FF ** -0.5),
        'final_norm_w': gain(ks[40], (d,)),
    }


def reference(x_prompt, x_sample, cache_k, cache_v, state_C, state_n, state_m, c, c_ctx,
              w_mod, b_mod, norm1_w, norm2_w,
              w_in0, lam_q1, lam_k1, lam_q2, lam_k2, subln_w, gate_norm_w, w_spatial, b_spatial, w_out0,
              w_in1, b_gates, mconv_w, mconv_b, w_q, w_k, w_v, head_norm_w, skip_w, w_out1,
              w_up, fconv_w, fconv_b, w_down, final_norm_w):
    f32 = jnp.float32

    x = x_prompt
    Bp = x_prompt.shape[0]
    ks, vs, Cs, ns, ms = [], [], [], [], []
    for l in range(DEPTH):
        sh1, sc1, g1, sh2, sc2, g2 = _ada(c_ctx, w_mod[l], b_mod[l])
        h = _modulate(x, norm1_w[l], sh1, sc1)
        if l % 2 == 0:
            e = l // 2
            y, k_ctx, v_ctx = _even_mixer(h, l, w_in0[e], lam_q1[e], lam_k1[e], lam_q2[e], lam_k2[e],
                                          subln_w[e], gate_norm_w[e], w_spatial[e], b_spatial[e], w_out0[e])
            ks.append(k_ctx)
            vs.append(v_ctx)
        else:
            o = l // 2
            zero = (jnp.zeros((Bp, C_HEADS, C_HD, C_HD), f32), jnp.zeros((Bp, C_HEADS, C_HD), f32),
                    jnp.zeros((Bp, C_HEADS), f32))
            y, st_f, st_b = _odd_mixer(h, zero, zero, w_in1[o], b_gates[o], mconv_w[o], mconv_b[o],
                                       w_q[o], w_k[o], w_v[o], head_norm_w[o], skip_w[o], w_out1[o])
            Cs.append(jnp.stack([st_f[0], st_b[0]], axis=1))
            ns.append(jnp.stack([st_f[1], st_b[1]], axis=1))
            ms.append(jnp.stack([st_f[2], st_b[2]], axis=1))
        x = x + g1 * y
        h = _modulate(x, norm2_w[l], sh2, sc2)
        x = x + g2 * _conv_ffn(h, w_up[l], fconv_w[l], fconv_b[l], w_down[l])
    y_prompt = _rmsnorm(x, final_norm_w)
    new_cache_k = jnp.stack(ks, axis=1)
    new_cache_v = jnp.stack(vs, axis=1)
    new_state_C = jnp.stack(Cs, axis=1)
    new_state_n = jnp.stack(ns, axis=1)
    new_state_m = jnp.stack(ms, axis=1)

    x = x_sample
    rope = _axial_rope_tables(x_sample.shape[1])
    for l in range(DEPTH):
        sh1, sc1, g1, sh2, sc2, g2 = _ada(c, w_mod[l], b_mod[l])
        h = _modulate(x, norm1_w[l], sh1, sc1)
        if l % 2 == 0:
            e = l // 2
            y, _, _ = _even_mixer(h, l, w_in0[e], lam_q1[e], lam_k1[e], lam_q2[e], lam_k2[e],
                                  subln_w[e], gate_norm_w[e], w_spatial[e], b_spatial[e], w_out0[e],
                                  rope=rope, ctx_k=cache_k[:, e], ctx_v=cache_v[:, e])
        else:
            o = l // 2
            init_f = (state_C[:, o, 0].astype(f32), state_n[:, o, 0].astype(f32), state_m[:, o, 0].astype(f32))
            init_b = (state_C[:, o, 1].astype(f32), state_n[:, o, 1].astype(f32), state_m[:, o, 1].astype(f32))
            y, _, _ = _odd_mixer(h, init_f, init_b, w_in1[o], b_gates[o], mconv_w[o], mconv_b[o],
                                 w_q[o], w_k[o], w_v[o], head_norm_w[o], skip_w[o], w_out1[o])
        x = x + g1 * y
        h = _modulate(x, norm2_w[l], sh2, sc2)
        x = x + g2 * _conv_ffn(h, w_up[l], fconv_w[l], fconv_b[l], w_down[l])
    y_sample = _rmsnorm(x, final_norm_w)

    return (y_prompt, y_sample, new_cache_k, new_cache_v, new_state_C, new_state_n, new_state_m)
```

```cpp
#include <hip/hip_runtime.h>
#include <hip/hip_cooperative_groups.h>
#include <cstdio>
#include <cstdint>
namespace cg = cooperative_groups;

#ifndef MK_PER_PHASE
#define MK_PER_PHASE 0
#endif

#define DI __device__ __forceinline__
#define LAS __attribute__((address_space(3)))
typedef unsigned short bf16_t;
typedef short bf16x8 __attribute__((ext_vector_type(8)));
typedef short s16x4 __attribute__((ext_vector_type(4)));
typedef float f32x2 __attribute__((ext_vector_type(2)));
typedef float f32x4 __attribute__((ext_vector_type(4)));
typedef float f32x16 __attribute__((ext_vector_type(16)));
typedef unsigned u32x2 __attribute__((ext_vector_type(2)));
typedef unsigned u32x4 __attribute__((ext_vector_type(4)));
typedef __bf16 bf16x2_t __attribute__((ext_vector_type(2)));

constexpr int D = 1024, T_CTX = 4096, T_SMP = 32768, T_ALL = 36864, SEQ_C = 256, SEQ_S = 4096, PAST = 512, LKS = 4608;
constexpr int DFF = 2816, NIN0 = 2560, NIN1P = 2304, NIN1 = 2064;
constexpr float EPS = 1e-6f;
constexpr float ATT_C2 = 0.125f * 1.4426950408889634f;
constexpr float LAM_INIT = 0.2f;

constexpr size_t MiB = 1u << 20;
constexpr size_t WS_BAR = 0;
constexpr size_t WS_ROWSQ = 64 * 1024;
constexpr size_t WS_RSQA = WS_ROWSQ + 147456, WS_RSQB = WS_RSQA + 147456, WS_RSQC = WS_RSQB + 147456;
constexpr size_t WS_ZERO_BYTES = 1024 * 1024;
constexpr size_t WS_MOD = 509 * MiB + 512 * 1024;
constexpr size_t WS_ROPE = 510 * MiB;
constexpr size_t WS_LAM = 510 * MiB + 16 * 1024;
constexpr size_t WS_BIAS = 510 * MiB + 256 * 1024;
constexpr int BIAS_UP0 = 0, BIAS_IN1 = 9 * 5632, BIAS_UP1 = BIAS_IN1 + 9 * 2304;
constexpr size_t SLOT = 72 * MiB;
constexpr size_t WS_S0 = 1 * MiB, WS_S1 = WS_S0 + SLOT, WS_S2 = WS_S1 + SLOT, WS_S3 = WS_S2 + SLOT, WS_S4 = WS_S3 + SLOT, WS_S5 = WS_S4 + SLOT, WS_S6 = WS_S5 + SLOT;
constexpr size_t WS_GATES = 505 * MiB;
constexpr size_t WS_WOUT1 = 507 * MiB + 512 * 1024;
constexpr size_t WS_END = 512 * MiB;
constexpr size_t WS_H = WS_S0;
constexpr size_t WS_Q = WS_S1, WS_KS = WS_S1 + 36 * MiB;
constexpr size_t WS_VS = WS_S2, WS_GU = WS_S2 + 36 * MiB;
constexpr size_t WS_GV = WS_S3, WS_KC = WS_S3 + 36 * MiB, WS_VC = WS_S3 + 40 * MiB;
constexpr size_t WS_MIX = WS_S4;
constexpr size_t WS_ASCR = WS_S5;
constexpr size_t WS_UBUF = 73 * MiB, WS_EDGE = 271 * MiB;
constexpr size_t WS_WUP = 469 * MiB, WS_WDOWN = 480 * MiB;
constexpr size_t WS_WIN0 = 486 * MiB, WS_WOUT0 = 491 * MiB;
constexpr size_t WS_XC = WS_S0, WS_XM = WS_S1, WS_HF = WS_S1, WS_OG = WS_S2, WS_Q1 = WS_S3, WS_Y1 = WS_S3, WS_K1 = WS_S4, WS_V1 = WS_S5, WS_HB = WS_S6;
constexpr size_t WS_WIN1 = 493 * MiB, WS_WQKV1 = 498 * MiB;
constexpr size_t WS_WUP1 = WS_S4, WS_WDOWN1 = WS_S4 + 11 * MiB;
static_assert(WS_S6 + SLOT == 505 * MiB && WS_WOUT1 + 2 * MiB <= WS_MOD && WS_GATES + (size_t)T_ALL * 64 <= WS_WOUT1 && WS_RSQC + 147456 <= WS_ZERO_BYTES && WS_BIAS + (size_t)(BIAS_UP1 + 9 * 5632) * 4 <= WS_END && WS_MOD + 442368 <= WS_ROPE, "ws map");
static_assert(WS_UBUF + (size_t)T_ALL * DFF * 2 == WS_EDGE && WS_EDGE + (size_t)144 * 6 * DFF * 4 <= WS_WUP && WS_WOUT0 + 2 * MiB <= WS_S6 + SLOT && WS_WIN0 >= WS_S6, "ws map 2");
static_assert(WS_WQKV1 + 3 * MiB / 2 <= WS_S6 + SLOT && WS_WIN1 >= WS_WOUT0 + 2 * MiB && WS_WDOWN1 + 6 * MiB <= WS_S5 && WS_WUP1 >= WS_EDGE + 10 * MiB, "ws map 3");

constexpr size_t OUT_Y = 0, OUT_CK = (size_t)T_ALL * D, OUT_CV = OUT_CK + 2097152, OUT_SC = OUT_CV + 2097152, OUT_SN = OUT_SC + 8388608, OUT_SM = OUT_SN + 32768;

constexpr int LDS_BYTES = 163840;
constexpr int MISC_OFF = 163840 - 256;

struct Params { const float* in[38]; float* out; unsigned char* ws; int ph_lo, ph_hi, never, pad; };
enum { I_XP = 0, I_XS, I_CK, I_CV, I_SC, I_SN, I_SM, I_C, I_CCTX, I_WMOD, I_BMOD, I_N1W, I_N2W, I_WIN0, I_LQ1, I_LK1, I_LQ2, I_LK2, I_SUBLN, I_GNW, I_WSP, I_BSP, I_WOUT0,
       I_WIN1, I_BG, I_MCW, I_MCB, I_WQ, I_WK, I_WV, I_HNW, I_SKIP, I_WOUT1, I_WUP, I_FCW, I_FCB, I_WDOWN, I_FNW };

DI unsigned cvtpk(float lo, float hi) { f32x2 v = {lo, hi}; bf16x2_t b = __builtin_convertvector(v, bf16x2_t); return __builtin_bit_cast(unsigned, b); }
DI float bf2f(unsigned short b) { return __uint_as_float(((unsigned)b) << 16); }
DI float bflo(unsigned w) { return __uint_as_float(w << 16); }
DI float bfhi(unsigned w) { return __uint_as_float(w & 0xffff0000u); }
DI float silu_f(float x) { return x * __builtin_amdgcn_rcpf(1.f + __builtin_amdgcn_exp2f(-1.4426950408889634f * x)); }
DI float sigmoid_f(float x) { return __builtin_amdgcn_rcpf(1.f + __builtin_amdgcn_exp2f(-1.4426950408889634f * x)); }
DI float gelu_f(float x) { const float t = x * x; const float u = x * (-2.302208198482644f - 0.10294324276f * t); return x * __builtin_amdgcn_rcpf(1.f + __builtin_amdgcn_exp2f(u)); }
DI f32x2 gelu_gate2(f32x2 x, f32x2 g) {
    const f32x2 t = x * x, u = x * (t * -0.10294324276f + -2.302208198482644f);
    f32x2 e; e.x = __builtin_amdgcn_exp2f(u.x); e.y = __builtin_amdgcn_exp2f(u.y);
    const f32x2 d = e + 1.f; f32x2 r; r.x = __builtin_amdgcn_rcpf(d.x); r.y = __builtin_amdgcn_rcpf(d.y);
    return (x * g) * r;
}
DI f32x4 gelu4(const f32x4& v) {
    const f32x2 a = {v[0], v[1]}, b = {v[2], v[3]};
    const f32x2 ta = a * a, tb = b * b, ua = a * (ta * -0.10294324276f + -2.302208198482644f), ub = b * (tb * -0.10294324276f + -2.302208198482644f);
    f32x2 ea, eb; ea.x = __builtin_amdgcn_exp2f(ua.x); ea.y = __builtin_amdgcn_exp2f(ua.y); eb.x = __builtin_amdgcn_exp2f(ub.x); eb.y = __builtin_amdgcn_exp2f(ub.y);
    const f32x2 da = ea + 1.f, db = eb + 1.f; f32x2 ra, rb; ra.x = __builtin_amdgcn_rcpf(da.x); ra.y = __builtin_amdgcn_rcpf(da.y); rb.x = __builtin_amdgcn_rcpf(db.x); rb.y = __builtin_amdgcn_rcpf(db.y);
    const f32x2 ya = a * ra, yb = b * rb; return (f32x4){ya.x, ya.y, yb.x, yb.y};
}
DI f32x4 sigmoid4(const f32x4& v) {
    const f32x2 a = {v[0], v[1]}, b = {v[2], v[3]}, ua = a * -1.4426950408889634f, ub = b * -1.4426950408889634f;
    f32x2 ea, eb; ea.x = __builtin_amdgcn_exp2f(ua.x); ea.y = __builtin_amdgcn_exp2f(ua.y); eb.x = __builtin_amdgcn_exp2f(ub.x); eb.y = __builtin_amdgcn_exp2f(ub.y);
    const f32x2 da = ea + 1.f, db = eb + 1.f;
    return (f32x4){__builtin_amdgcn_rcpf(da.x), __builtin_amdgcn_rcpf(da.y), __builtin_amdgcn_rcpf(db.x), __builtin_amdgcn_rcpf(db.y)};
}
DI float logsigmoid_f(float x) { return fminf(x, 0.f) - __logf(1.f + __expf(-fabsf(x))); }
DI float wave_sum(float v) {
#pragma unroll
    for (int o = 1; o < 64; o <<= 1) v += __shfl_xor(v, o);
    return v;
}
DI float max3f(float a, float b, float c) { float r; asm("v_max3_f32 %0, %1, %2, %3" : "=v"(r) : "v"(a), "v"(b), "v"(c)); return r; }
DI float max2f(float a, float b) { float r; asm("v_max_f32_e32 %0, %1, %2" : "=v"(r) : "v"(a), "v"(b)); return r; }
DI float xhalf_max(float v) { auto rr = __builtin_amdgcn_permlane32_swap(__float_as_uint(v), __float_as_uint(v), false, false); return max2f(__uint_as_float(rr[0]), __uint_as_float(rr[1])); }
DI float xhalf_sum(float v) { auto rr = __builtin_amdgcn_permlane32_swap(__float_as_uint(v), __float_as_uint(v), false, false); return __uint_as_float(rr[0]) + __uint_as_float(rr[1]); }
DI int crow(int reg, int h) { return (reg & 3) + 8 * (reg >> 2) + 4 * h; }
#define MFMA32(a, b, c) __builtin_amdgcn_mfma_f32_32x32x16_bf16((a), (b), (c), 0, 0, 0)
typedef short v4i16_t __attribute__((ext_vector_type(4)));
DI s16x4 ldtr(LAS const unsigned char* p) { return __builtin_bit_cast(s16x4, __builtin_amdgcn_ds_read_tr16_b64_v4i16((LAS v4i16_t*)p)); }
DI bf16x8 cat8(s16x4 lo, s16x4 hi) { return __builtin_shufflevector(lo, hi, 0, 1, 2, 3, 4, 5, 6, 7); }
DI bf16x8 pack8(const f32x16& x, int s) {
    u32x4 p; p[0] = cvtpk(x[8 * s], x[8 * s + 1]); p[1] = cvtpk(x[8 * s + 2], x[8 * s + 3]); p[2] = cvtpk(x[8 * s + 4], x[8 * s + 5]); p[3] = cvtpk(x[8 * s + 6], x[8 * s + 7]);
    return __builtin_bit_cast(bf16x8, p);
}
#define LDS_WAIT() asm volatile("s_waitcnt lgkmcnt(0)" ::: "memory")

#define XB_TMO      128
#define XB_XCNT(j)  (256  + 64 * (j))
#define XB_XSUB(j)  (1280 + 64 * (j))
#define XB_XGEN(j)  (2304 + 64 * (j))
#define XB_TOP      3328
#define XB_TOPGEN   3392
#define XCD_BAR_WORDS 3456
#define XB_SPIN_CAP (1u << 22)
DI unsigned xb_ld(unsigned* p)              { return __hip_atomic_load(p, __ATOMIC_RELAXED, __HIP_MEMORY_SCOPE_AGENT); }
DI unsigned xb_add(unsigned* p, unsigned v) { return __hip_atomic_fetch_add(p, v, __ATOMIC_RELAXED, __HIP_MEMORY_SCOPE_AGENT); }
DI int hw_lane() { int l_; asm volatile("v_mbcnt_lo_u32_b32 %0, -1, 0\n\tv_mbcnt_hi_u32_b32 %0, -1, %0" : "=v"(l_)); return l_; }
DI unsigned xb_xcc_id() { return (unsigned)__builtin_amdgcn_s_getreg((3 << 11) | 20) & 0xFu; }
#define XB_SPIN(cond, bar) do { unsigned _sp = 0; while (cond) { __builtin_amdgcn_s_sleep(1); \
    if ((++_sp & 255u) == 0u) { if (xb_ld(&(bar)[XB_TMO])) break; if (_sp > XB_SPIN_CAP) { atomicAdd(&(bar)[XB_TMO], 1u); break; } } } } while (0)
struct XcdBarrier { unsigned* bar; unsigned x; volatile LAS unsigned* st; int wave; };
DI XcdBarrier xcd_barrier_post(unsigned* bar, volatile LAS unsigned* st, int wave) {
    XcdBarrier b; b.bar = bar; b.x = xb_xcc_id(); b.st = st; b.wave = wave;
    if (wave == 0 && hw_lane() == 0) (void)xb_add(&bar[XB_XCNT(b.x)], 1u);
    return b;
}
DI void xcd_barrier_complete(unsigned* bar, unsigned x, unsigned& nloc, unsigned& nx) {
    const unsigned G = gridDim.x * gridDim.y * gridDim.z;
    unsigned sum, cnt, mine, sp = 0u;
    for (;;) {
        sum = 0u; cnt = 0u; mine = 0u;
#pragma unroll
        for (unsigned j = 0; j < 16; ++j) { const unsigned c = xb_ld(&bar[XB_XCNT(j)]); sum += c; cnt += (c > 0u) ? 1u : 0u; mine = (j == x) ? c : mine; }
        if (sum == G) break;
        __builtin_amdgcn_s_sleep(1);
        if ((++sp & 255u) == 0u) { if (xb_ld(&bar[XB_TMO])) break; if (sp > XB_SPIN_CAP) { atomicAdd(&bar[XB_TMO], 1u); break; } }
    }
    nloc = mine > 0u ? mine : 1u; nx = cnt > 0u ? cnt : 1u;
}
DI void xcd_barrier(const XcdBarrier& b) {
    asm volatile("s_waitcnt vmcnt(0)" ::: "memory");
    __syncthreads();
    if (b.wave == 0 && hw_lane() == 0) {
        unsigned* bar = b.bar;
        __builtin_amdgcn_s_waitcnt(0);
        unsigned nloc = b.st[0], nx = b.st[1];
        if (nloc == 0u) { xcd_barrier_complete(bar, b.x, nloc, nx); b.st[0] = nloc; b.st[1] = nx; }
        const unsigned old = xb_add(&bar[XB_XSUB(b.x)], 1u);
        const unsigned gen = old / nloc;
        if (old + 1u == (gen + 1u) * nloc) {
            __builtin_amdgcn_fence(__ATOMIC_RELEASE, "agent");
            asm volatile("s_waitcnt vmcnt(0)" ::: "memory");
            const unsigned og = xb_add(&bar[XB_TOP], 1u);
            const unsigned tg = og / nx;
            if (og + 1u == (tg + 1u) * nx) xb_add(&bar[XB_TOPGEN], 1u);
            else XB_SPIN(xb_ld(&bar[XB_TOPGEN]) == tg, bar);
            __builtin_amdgcn_fence(__ATOMIC_ACQUIRE, "agent");
            xb_add(&bar[XB_XGEN(b.x)], 1u);
            asm volatile("s_waitcnt vmcnt(0)" ::: "memory");
        } else {
            XB_SPIN(xb_ld(&bar[XB_XGEN(b.x)]) == gen, bar);
            __builtin_amdgcn_fence(__ATOMIC_ACQUIRE, "agent");
            asm volatile("s_waitcnt vmcnt(0)" ::: "memory");
        }
    }
    __syncthreads();
}

namespace pg8 {
constexpr int BM = 256, BK = 64, HALF = 128, HTB = HALF * BK * 2, STAGE_BYTES = 8 * HTB, NXCD = 8, WGM = 8;
DI int lds_byte(int r, int c) { const int st = (r >> 4) * 2 + (c >> 5), rr = r & 15, cc = c & 31, ob = rr * 64 + cc * 2; return st * 1024 + (ob ^ (((ob >> 9) & 1) << 5)); }
DI void stage_rc(int b, int& R, int& C) { const int st = b / 1024, sb = b % 1024, swz = sb ^ (((sb >> 9) & 1) << 5); R = (st >> 1) * 16 + swz / 64; C = (st & 1) * 32 + (swz % 64) / 2; }
DI int perm32(int rho) { const int n = rho >> 4, i = rho & 15; return 8 * (i >> 2) + 4 * n + (i & 3); }
struct Unit { int pm, pn, aux; };
struct PlainOrder {
    const bf16_t* A; const bf16_t* Bt; int lda, K, nM, nN, nwg, G, c;
    DI void init(const bf16_t* A_, const bf16_t* Bt_, int lda_, int K_, int M, int N, int G_, int c_) { A = A_; Bt = Bt_; lda = lda_; K = K_; nM = M / BM; nN = N / BM; nwg = nM * nN; G = G_; c = c_; }
    DI bool next(int i, Unit& u) const {
        const long L = (long)i * G + c; if (L >= nwg) return false;
        int wgid = (int)L; { const int q = nwg / NXCD, r = nwg % NXCD, xcd = wgid % NXCD, off = wgid / NXCD; wgid = (xcd < r ? xcd * (q + 1) : r * (q + 1) + (xcd - r) * q) + off; }
        const int nig = WGM * nN, gid = wgid / nig, fm = gid * WGM, gsz = (nM - fm) < WGM ? (nM - fm) : WGM;
        u.pm = fm + ((wgid % nig) % gsz); u.pn = (wgid % nig) / gsz; u.aux = 0; return true;
    }
    DI const char* a_ptr(const Unit& u) const { return (const char*)A + (size_t)u.pm * BM * lda * 2; }
    DI const char* b_ptr(const Unit& u) const { return (const char*)Bt + (size_t)u.pn * BM * K * 2; }
};

struct PanelOrder {
    const bf16_t* A; const bf16_t* Bt; int lda, K, nwg, G, c, r_lo, r_hi;
    DI void init(const bf16_t* A_, const bf16_t* Bt_, int lda_, int K_, int M, int G_, int c_, int r_lo_, int r_hi_) { A = A_; Bt = Bt_; lda = lda_; K = K_; nwg = (M / BM) * 4; G = G_; c = c_; r_lo = r_lo_; r_hi = r_hi_; }
    DI bool next(int i, Unit& u) const {
        const int rnd = i + r_lo; if (rnd >= r_hi) return false;
        const long L = (long)rnd * G + c; if (L >= nwg) return false;
        const int x = (int)(L % 8), off = (int)(L / 8);
        u.pm = 8 * (off >> 2) + x; u.pn = off & 3; u.aux = 0; return true;
    }
    DI const char* a_ptr(const Unit& u) const { return (const char*)A + (size_t)u.pm * BM * lda * 2; }
    DI const char* b_ptr(const Unit& u) const { return (const char*)Bt + (size_t)u.pn * BM * K * 2; }
};

struct SplitOrder {
    const bf16_t* A; const bf16_t* Bt; int lda, K, nN, x, start, stride, lc, max_i, total;
    DI void init(const bf16_t* A_, const bf16_t* Bt_, int lda_, int K_, int nN_, int c, bool early, int e) {
        A = A_; Bt = Bt_; lda = lda_; K = K_; nN = nN_; x = c & 7; total = 18 * nN_;
        if (early) { start = 0; stride = 24; lc = (c - 64) >> 3; max_i = (c >= 64) ? e : 0; }
        else { start = 24 * e; stride = 32; lc = c >> 3; max_i = 1 << 20; }
    }
    DI bool next(int i, Unit& u) const {
        if (i >= max_i) return false;
        const int lu = start + i * stride + lc; if (lu >= total) return false;
        const int g8 = 8 * nN, g = (lu < 2 * g8) ? lu / g8 : 2, r = lu - g * g8, gsz = (g < 2) ? 8 : 2;
        u.pm = 8 * (8 * g + r % gsz) + x; u.pn = r / gsz; u.aux = 0; return true;
    }
    DI const char* a_ptr(const Unit& u) const { return (const char*)A + (size_t)u.pm * BM * lda * 2; }
    DI const char* b_ptr(const Unit& u) const { return (const char*)Bt + (size_t)u.pn * BM * K * 2; }
};

template <class Epi, class Sched>
DI void gemm_phase(LAS unsigned char* lds, const Sched& S, const Epi& E, const int lda, const int K, const int tid) {
    const int wid = __builtin_amdgcn_readfirstlane(tid >> 6), lane = tid & 63, wr = wid >> 2, wc = wid & 3, fr = lane & 15, fq = lane >> 4;
    const int nt = K / BK;
    unsigned voffA[2], voffB[2];
#pragma unroll
    for (int i = 0; i < 2; ++i) { int R, C; stage_rc(tid * 16 + i * 8192, R, C); const int Rb = Epi::PERM ? ((R >> 5) * 64 + perm32(R & 31)) : R;
        const int Ra = Epi::AROW4 ? ((R & ~63) + 4 * (R & 15) + ((R >> 4) & 3)) : R;
        voffA[i] = (unsigned)(Ra * lda + C) * 2u; voffB[i] = (unsigned)(Rb * K + C) * 2u; }
    const size_t kstep = (size_t)(BK * 2);
    const size_t hstepA = (size_t)HALF * lda * 2, hstepB = (size_t)(Epi::PERM ? 32 : HALF) * K * 2;
    const unsigned ldsw = (unsigned)wid * 1024u;
    const int aoff = lds_byte(wr * 64 + fr, fq * 8), boff = lds_byte(wc * 32 + fr, fq * 8);
#define PG8_SA(b, h) (((b) * 2 + (h)) * HTB)
#define PG8_SB(b, h) ((4 + (b) * 2 + (h)) * HTB)
#define PG8_STAGE(bufoff, gbase, voff) do { _Pragma("unroll") for (int _i = 0; _i < 2; ++_i) \
        __builtin_amdgcn_global_load_lds((const unsigned*)((const char*)(gbase) + (voff)[_i]), (LAS unsigned*)(lds + (bufoff) + ldsw + _i * 8192), 16, 0, 0); } while (0)
#define PG8_LDA(dst, b, h) do { _Pragma("unroll") for (int m = 0; m < 4; ++m) _Pragma("unroll") for (int k = 0; k < 2; ++k) dst[m][k] = *(const LAS bf16x8*)(lds + PG8_SA(b, h) + aoff + m * 2048 + k * 1024); } while (0)
#define PG8_LDB(dst, b, h) do { _Pragma("unroll") for (int n = 0; n < 2; ++n) _Pragma("unroll") for (int k = 0; k < 2; ++k) dst[n][k] = *(const LAS bf16x8*)(lds + PG8_SB(b, h) + boff + n * 2048 + k * 1024); } while (0)
#define PG8_MMA(ai, bj, At, Bt) do { __builtin_amdgcn_s_setprio(1); _Pragma("unroll") for (int m = 0; m < 4; ++m) _Pragma("unroll") for (int n = 0; n < 2; ++n) _Pragma("unroll") for (int k = 0; k < 2; ++k) \
        acc[ai][bj][m][n] = __builtin_amdgcn_mfma_f32_16x16x32_bf16(Bt[n][k], At[m][k], acc[ai][bj][m][n], 0, 0, 0); __builtin_amdgcn_s_setprio(0); } while (0)
#define PG8_WAIT_V(n) asm volatile("s_waitcnt vmcnt(" #n ")" ::: "memory")
#define PG8_WAIT_L(n) asm volatile("s_waitcnt lgkmcnt(" #n ")" ::: "memory")
#define PG8_BAR __builtin_amdgcn_s_barrier()
#define PG8_SCHED __builtin_amdgcn_sched_barrier(0)
    Unit cur, nxt; int ui = 0;
    if (!S.next(0, cur)) return;
    f32x4 acc[2][2][4][2];
#pragma unroll
    for (int a = 0; a < 2; ++a)
#pragma unroll
        for (int b = 0; b < 2; ++b)
#pragma unroll
            for (int m = 0; m < 4; ++m)
#pragma unroll
                for (int n = 0; n < 2; ++n) acc[a][b][m][n] = (f32x4){0.f, 0.f, 0.f, 0.f};
    bf16x8 At[4][2], B0[2][2], B1[2][2];
    const char* cA = S.a_ptr(cur); const char* cB = S.b_ptr(cur);
    PG8_STAGE(PG8_SB(0, 0), cB, voffB); PG8_STAGE(PG8_SB(0, 1), cB + hstepB, voffB); PG8_STAGE(PG8_SA(0, 0), cA, voffA); PG8_STAGE(PG8_SA(0, 1), cA + hstepA, voffA);
    if (wr == 1) PG8_BAR;
    PG8_WAIT_V(2); PG8_BAR;
    PG8_STAGE(PG8_SB(1, 0), cB + kstep, voffB); PG8_STAGE(PG8_SA(1, 0), cA + kstep, voffA); PG8_STAGE(PG8_SB(1, 1), cB + hstepB + kstep, voffB);
    PG8_WAIT_V(6); PG8_BAR;
    for (;;) {
        const bool has_next = S.next(ui + 1, nxt);
        const char* nA = has_next ? S.a_ptr(nxt) : cA; const char* nB = has_next ? S.b_ptr(nxt) : cB;
        for (int t = 0; t < nt; t += 2) {
            const bool last = (t == nt - 2);
            const char* a1 = cA + (size_t)(t + 1) * kstep;
            const char* a2 = last ? nA : cA + (size_t)(t + 2) * kstep; const char* b2 = last ? nB : cB + (size_t)(t + 2) * kstep;
            const char* a3 = a2 + kstep; const char* b3 = b2 + kstep;
            PG8_LDB(B0, 0, 0); PG8_LDB(B1, 0, 1); PG8_SCHED; PG8_LDA(At, 0, 0); PG8_STAGE(PG8_SA(1, 1), a1 + hstepA, voffA);
            PG8_WAIT_V(8); PG8_WAIT_L(0); PG8_BAR; PG8_MMA(0, 0, At, B0); PG8_MMA(0, 1, At, B1); PG8_BAR; PG8_SCHED;
            PG8_LDA(At, 0, 1); PG8_STAGE(PG8_SB(0, 0), b2, voffB); PG8_STAGE(PG8_SB(0, 1), b2 + hstepB, voffB); PG8_STAGE(PG8_SA(0, 0), a2, voffA);
            PG8_WAIT_V(8); PG8_WAIT_L(0); PG8_BAR; PG8_MMA(1, 0, At, B0); PG8_MMA(1, 1, At, B1); PG8_BAR; PG8_SCHED;
            PG8_LDB(B0, 1, 0); PG8_LDB(B1, 1, 1); PG8_SCHED; PG8_LDA(At, 1, 0); PG8_STAGE(PG8_SA(0, 1), a2 + hstepA, voffA);
            PG8_WAIT_V(8); PG8_WAIT_L(0); PG8_BAR; PG8_MMA(0, 0, At, B0); PG8_MMA(0, 1, At, B1); PG8_BAR; PG8_SCHED;
            PG8_LDA(At, 1, 1); PG8_STAGE(PG8_SB(1, 0), b3, voffB); PG8_STAGE(PG8_SB(1, 1), b3 + hstepB, voffB); PG8_STAGE(PG8_SA(1, 0), a3, voffA);
            PG8_WAIT_V(8); PG8_WAIT_L(0); PG8_BAR; PG8_MMA(1, 0, At, B0); PG8_MMA(1, 1, At, B1); PG8_BAR; PG8_SCHED;
        }
        if (wr == 0) PG8_BAR;
        { const int l_ = hw_lane(); E(acc, cur, wr, wc, l_ & 15, l_ >> 4); }
        if (!has_next) break;
#pragma unroll
        for (int a = 0; a < 2; ++a)
#pragma unroll
            for (int b = 0; b < 2; ++b)
#pragma unroll
                for (int m = 0; m < 4; ++m)
#pragma unroll
                    for (int n = 0; n < 2; ++n) acc[a][b][m][n] = (f32x4){0.f, 0.f, 0.f, 0.f};
        cur = nxt; cA = nA; cB = nB; ++ui;
        if (wr == 1) PG8_BAR;
    }
    PG8_WAIT_V(0);
    PG8_BAR;
#undef PG8_SA
#undef PG8_SB
#undef PG8_STAGE
#undef PG8_LDA
#undef PG8_LDB
#undef PG8_MMA
#undef PG8_WAIT_V
#undef PG8_WAIT_L
#undef PG8_BAR
#undef PG8_SCHED
}
}

struct Frame {
    LAS unsigned char* lds; int tid, lane, wave, vcu, G, gw, NGW;
};


typedef pg8::Unit Unit;
DI void st_bf16x8(bf16_t* p, const f32x4& a, const f32x4& b) { u32x4 w; w.x = cvtpk(a[0], a[1]); w.y = cvtpk(a[2], a[3]); w.z = cvtpk(b[0], b[1]); w.w = cvtpk(b[2], b[3]); *(u32x4*)p = w; }

struct EpiNull { static constexpr bool PERM = true; static constexpr bool AROW4 = false; float* sink; DI void operator()(f32x4 (&acc)[2][2][4][2], const Unit& u, int wr, int wc, int fr, int fq) const {
        if (acc[0][0][0][0][0] == 1.2345e33f) *sink = 1.f; } };
struct EpiIn0 {
    static constexpr bool PERM = true; static constexpr bool AROW4 = false;
    bf16_t *Q, *KS, *VS, *KC, *VC, *GU, *GV; float *ck, *cv, *rowsq; const float* rope;
    DI void operator()(f32x4 (&acc)[2][2][4][2], const Unit& u, int wr, int wc, int fr, int fq) const {
        asm volatile("" : "+v"(fr), "+v"(fq));
        const int region = u.pn >> 1;
        const bool smp = (u.pm >= T_CTX / 256);
        const int cbase = (u.pn & 1) * 256 + wc * 64 + fq * 8;
#pragma unroll
        for (int ai = 0; ai < 2; ++ai)
#pragma unroll
            for (int m = 0; m < 4; ++m) {
                const int row = u.pm * 256 + ai * 128 + wr * 64 + m * 16 + fr;
                const int srow = row - T_CTX, sb = srow >> 12, pos = srow & 4095;
                float ss = 0.f;
#pragma unroll
                for (int bj = 0; bj < 2; ++bj) {
                    const int col = cbase + bj * 32;
                    f32x4 v0 = acc[ai][bj][m][0], v1 = acc[ai][bj][m][1];
                    if (region <= 1) {
                        if (smp) {
                            f32x4 p0, p1;
#pragma unroll
                            for (int i = 0; i < 4; ++i) { p0[i] = __shfl_xor(v0[i], 32); p1[i] = __shfl_xor(v1[i], 32); }
                            const int coord = (bj & 1) ? (pos & 63) : (pos >> 6);
                            const float* tc = rope + coord * 16 + (fq & 1) * 8; const float* tsn = tc + 1024;
                            const f32x4 c0 = *(const f32x4*)tc, c1 = *(const f32x4*)(tc + 4), s0 = *(const f32x4*)tsn, s1 = *(const f32x4*)(tsn + 4);
                            const float sg = (fq & 2) ? 1.f : -1.f;
                            v0 = v0 * c0 + (p0 * s0) * sg; v1 = v1 * c1 + (p1 * s1) * sg;
                        }
                        if (region == 0) { v0 = v0 * ATT_C2; v1 = v1 * ATT_C2; st_bf16x8(Q + (size_t)row * 512 + col, v0, v1); }
                        else if (smp) st_bf16x8(KS + ((size_t)sb * LKS + PAST + pos) * 512 + col, v0, v1);
                        else { float* o = ck + (size_t)row * 512 + col; *(f32x4*)o = v0; *(f32x4*)(o + 4) = v1; st_bf16x8(KC + (size_t)row * 512 + col, v0, v1); }
                    } else if (region == 2) {
                        if (smp) st_bf16x8(VS + ((size_t)sb * LKS + PAST + pos) * 512 + col, v0, v1);
                        else { float* o = cv + (size_t)row * 512 + col; *(f32x4*)o = v0; *(f32x4*)(o + 4) = v1; st_bf16x8(VC + (size_t)row * 512 + col, v0, v1); }
                    } else {
#pragma unroll
                        for (int i = 0; i < 1; ++i) { v0 = gelu4(v0); v1 = gelu4(v1); }
                        if (region == 3) st_bf16x8(GU + (size_t)row * 512 + col, v0, v1);
                        else { st_bf16x8(GV + (size_t)row * 512 + col, v0, v1);
#pragma unroll
                            for (int i = 0; i < 4; ++i) ss += v0[i] * v0[i] + v1[i] * v1[i]; }
                    }
                }
                if (region == 4) { ss += __shfl_xor(ss, 16); ss += __shfl_xor(ss, 32); if (fq == 0) atomicAdd(rowsq + row, ss); }
            }
    }
};

DI f32x4 bf16x4_lo(const u32x4& w) { return (f32x4){__uint_as_float(w.x << 16), __uint_as_float(w.x & 0xffff0000u), __uint_as_float(w.y << 16), __uint_as_float(w.y & 0xffff0000u)}; }
DI f32x4 bf16x4_hi(const u32x4& w) { return (f32x4){__uint_as_float(w.z << 16), __uint_as_float(w.z & 0xffff0000u), __uint_as_float(w.w << 16), __uint_as_float(w.w & 0xffff0000u)}; }
template <bool NEXT, bool BF32> struct EpiRes {
    static constexpr bool PERM = true; static constexpr bool AROW4 = false;
    const float* base_c; const float* base_s; const bf16_t* xb; bf16_t* xo; const float* mod; int gate_off;
    bf16_t* Hn; const float* nw; const float* modn; int sc_off; float* rsq;
    DI void operator()(f32x4 (&acc)[2][2][4][2], const Unit& u, int wr, int wc, int fr, int fq) const {
        asm volatile("" : "+v"(fr), "+v"(fq));
        const int row0 = u.pm * 256 + wr * 64 + fr, col0 = u.pn * 256 + wc * 64 + 8 * fq;
        const bool smp = (u.pm >= T_CTX / 256);
        const int cond = smp ? ((u.pm * 256 - T_CTX) >> 12) : 8;
        const float* g = mod + cond * 6144 + gate_off + col0;
        f32x4 gv[2][2], nv[2][2];
#pragma unroll
        for (int bj = 0; bj < 2; ++bj)
#pragma unroll
            for (int n = 0; n < 2; ++n) { gv[bj][n] = *(const f32x4*)(g + bj * 32 + n * 4);
                if (NEXT) nv[bj][n] = *(const f32x4*)(nw + col0 + bj * 32 + n * 4) * (*(const f32x4*)(modn + cond * 6144 + sc_off + col0 + bj * 32 + n * 4) + 1.f); }
#pragma unroll
        for (int ai = 0; ai < 2; ++ai)
#pragma unroll
            for (int m = 0; m < 4; ++m) {
                const int row = row0 + ai * 128 + m * 16;
                f32x4 b[2][2];
#pragma unroll
                for (int bj = 0; bj < 2; ++bj) {
                    if (BF32) { const float* bp = (smp ? base_s + (size_t)(row - T_CTX) * D : base_c + (size_t)row * D) + col0 + bj * 32; b[bj][0] = *(const f32x4*)bp; b[bj][1] = *(const f32x4*)(bp + 4); }
                    else { const u32x4 w = *(const u32x4*)(xb + (size_t)row * D + col0 + bj * 32); b[bj][0] = bf16x4_lo(w); b[bj][1] = bf16x4_hi(w); } }
                float ss = 0.f;
#pragma unroll
                for (int bj = 0; bj < 2; ++bj) {
                    const f32x4 x0 = b[bj][0] + gv[bj][0] * acc[ai][bj][m][0], x1 = b[bj][1] + gv[bj][1] * acc[ai][bj][m][1];
                    st_bf16x8(xo + (size_t)row * D + col0 + bj * 32, x0, x1);
                    if (NEXT) { ss += ((x0.x * x0.x + x0.y * x0.y) + (x0.z * x0.z + x0.w * x0.w)) + ((x1.x * x1.x + x1.y * x1.y) + (x1.z * x1.z + x1.w * x1.w));
                        st_bf16x8(Hn + (size_t)row * D + col0 + bj * 32, x0 * nv[bj][0], x1 * nv[bj][1]); } }
                if (NEXT) { ss += __shfl_xor(ss, 16); ss += __shfl_xor(ss, 32); if (fq == 0) atomicAdd(rsq + row, ss); }
            }
    }
};

template <int CTRL> DI float dppf(float old, float src) { return __int_as_float(__builtin_amdgcn_update_dpp(__float_as_int(old), __float_as_int(src), CTRL, 0xf, 0xf, false)); }
template <int CTRL> DI float dppm(float src) { return __int_as_float(__builtin_amdgcn_mov_dpp(__float_as_int(src), CTRL, 0xf, 0xf, false)); }
constexpr int DPP_SHL1 = 0x101, DPP_SHR1 = 0x111, DPP_ROR1 = 0x121, DPP_ROR15 = 0x12F;
constexpr int EDS_OFF = 131072;
struct EpiUpConv {
    static constexpr bool PERM = true; static constexpr bool AROW4 = true;
    bf16_t* U; float* edge; const float* cw; const float* cb; LAS float* eds; const float* rsq; const float* bias;
    DI void operator()(f32x4 (&acc)[2][2][4][2], const Unit& u, int wr, int wc, int fr, int fq) const {
        asm volatile("" : "+v"(fr), "+v"(fq));
        const int col0 = u.pn * 128 + wc * 32 + fq * 8, ecol = wc * 32 + fq * 8;
        {
            const int cond = (u.pm >= T_CTX / 256) ? ((u.pm * 256 - T_CTX) >> 12) : 8;
            const float* bp = bias + cond * (2 * DFF) + col0;
            const f32x4 ba0 = *(const f32x4*)bp, ba1 = *(const f32x4*)(bp + 4), bg0 = *(const f32x4*)(bp + DFF), bg1 = *(const f32x4*)(bp + DFF + 4);
#pragma unroll
            for (int ai = 0; ai < 2; ++ai)
#pragma unroll
                for (int m = 0; m < 4; ++m) { const float rstd = rsqrtf(rsq[u.pm * 256 + ai * 128 + wr * 64 + 4 * fr + m] * (1.f / D) + EPS);
                    acc[ai][0][m][0] = acc[ai][0][m][0] * rstd + ba0; acc[ai][0][m][1] = acc[ai][0][m][1] * rstd + ba1;
                    acc[ai][1][m][0] = acc[ai][1][m][0] * rstd + bg0; acc[ai][1][m][1] = acc[ai][1][m][1] * rstd + bg1; }
        }
#pragma unroll
        for (int ai = 0; ai < 2; ++ai) { const int blk = ai * 2 + wr;
            if (fr == 0)  { *(LAS f32x4*)(eds + (blk * 2 + 0) * 128 + ecol) = acc[ai][0][0][0]; *(LAS f32x4*)(eds + (blk * 2 + 0) * 128 + ecol + 4) = acc[ai][0][0][1]; }
            if (fr == 15) { *(LAS f32x4*)(eds + (blk * 2 + 1) * 128 + ecol) = acc[ai][0][3][0]; *(LAS f32x4*)(eds + (blk * 2 + 1) * 128 + ecol + 4) = acc[ai][0][3][1]; } }
        f32x4 w0[2], w1[2], w2[2], bb[2];
#pragma unroll
        for (int n = 0; n < 2; ++n) { w0[n] = *(const f32x4*)(cw + col0 + 4 * n); w1[n] = *(const f32x4*)(cw + DFF + col0 + 4 * n); w2[n] = *(const f32x4*)(cw + 2 * DFF + col0 + 4 * n); bb[n] = *(const f32x4*)(cb + col0 + 4 * n); }
        const bool smp = u.pm >= T_CTX / 256;
        const bool seq_top = !smp || (((u.pm - T_CTX / 256) & 15) == 0), seq_bot = !smp || (((u.pm - T_CTX / 256) & 15) == 15);
        const f32x4 z4 = {0.f, 0.f, 0.f, 0.f};
        f32x4 pe[2][2] = {{z4, z4}, {z4, z4}}, ne[2][2] = {{z4, z4}, {z4, z4}};
#define UPC_GROUP(AI, M) do { \
                const size_t row = (size_t)(u.pm * 256 + (AI) * 128 + wr * 64 + 4 * fr + (M)); \
                f32x4 tt[2], oo[2]; \
                _Pragma("unroll") for (int n = 0; n < 2; ++n) { \
                    const f32x4 a = acc[AI][0][M][n], g = acc[AI][1][M][n]; f32x4 pv, nv; \
                    _Pragma("unroll") for (int i = 0; i < 4; ++i) { \
                        pv[i] = ((M) > 0) ? acc[AI][0][(M) > 0 ? (M) - 1 : 0][n][i] : dppf<DPP_SHR1>(pe[AI][n][i], acc[AI][0][3][n][i]);     \
                        nv[i] = ((M) < 3) ? acc[AI][0][(M) < 3 ? (M) + 1 : 3][n][i] : dppf<DPP_SHL1>(ne[AI][n][i], acc[AI][0][0][n][i]); }   \
                    tt[n] = w0[n] * pv + w1[n] * a + w2[n] * nv + bb[n]; \
                    { const f32x2 lo = gelu_gate2((f32x2){tt[n][0], tt[n][1]}, (f32x2){g[0], g[1]}), hi = gelu_gate2((f32x2){tt[n][2], tt[n][3]}, (f32x2){g[2], g[3]}); \
                      oo[n][0] = lo.x; oo[n][1] = lo.y; oo[n][2] = hi.x; oo[n][3] = hi.y; } \
                } \
                st_bf16x8(U + row * DFF + col0, oo[0], oo[1]); \
                  \
                if ((M) == 0 && (AI) * 2 + wr == 0 && !seq_top && fr == 0) { float* e = edge + ((size_t)(u.pm * 2 + 0) * 3) * DFF + col0; \
                    *(f32x4*)e = tt[0]; *(f32x4*)(e + 4) = tt[1]; *(f32x4*)(e + DFF) = acc[AI][0][M][0]; *(f32x4*)(e + DFF + 4) = acc[AI][0][M][1]; *(f32x4*)(e + 2 * DFF) = acc[AI][1][M][0]; *(f32x4*)(e + 2 * DFF + 4) = acc[AI][1][M][1]; } \
                if ((M) == 3 && (AI) * 2 + wr == 3 && !seq_bot && fr == 15) { float* e = edge + ((size_t)(u.pm * 2 + 1) * 3) * DFF + col0; \
                    *(f32x4*)e = tt[0]; *(f32x4*)(e + 4) = tt[1]; *(f32x4*)(e + DFF) = acc[AI][0][M][0]; *(f32x4*)(e + DFF + 4) = acc[AI][0][M][1]; *(f32x4*)(e + 2 * DFF) = acc[AI][1][M][0]; *(f32x4*)(e + 2 * DFF + 4) = acc[AI][1][M][1]; } \
            } while (0)
        UPC_GROUP(0, 1); UPC_GROUP(0, 2); UPC_GROUP(1, 1); UPC_GROUP(1, 2);
        asm volatile("s_waitcnt lgkmcnt(0)" ::: "memory"); __builtin_amdgcn_s_barrier(); asm volatile("" ::: "memory");
#pragma unroll
        for (int ai = 0; ai < 2; ++ai) { const int blk = ai * 2 + wr;
#pragma unroll
            for (int n = 0; n < 2; ++n) { pe[ai][n] = (blk > 0) ? *(const LAS f32x4*)(eds + ((blk - 1) * 2 + 1) * 128 + ecol + 4 * n) : z4;
                                          ne[ai][n] = (blk < 3) ? *(const LAS f32x4*)(eds + ((blk + 1) * 2 + 0) * 128 + ecol + 4 * n) : z4; } }
        UPC_GROUP(0, 0); UPC_GROUP(0, 3); UPC_GROUP(1, 0); UPC_GROUP(1, 3);
#undef UPC_GROUP
    }
};
DI void ffn_fix_row(bf16_t* U, const float* edge, const float* cw, int pm, int side, int c) {
    const float* mine = edge + ((size_t)(pm * 2 + (side ? 0 : 1)) * 3) * DFF + c;
    const float* other = edge + ((size_t)((side ? pm - 1 : pm + 1) * 2 + (side ? 1 : 0)) * 3) * DFF + c;
    const float* w = cw + (side ? 0 : 2 * DFF) + c;
    float o[8];
#pragma unroll
    for (int i = 0; i < 8; ++i) o[i] = gelu_f(mine[i] + w[i] * other[DFF + i]) * mine[2 * DFF + i];
    const size_t row = (size_t)pm * 256 + (side ? 0 : 255);
    u32x4 pk; pk.x = cvtpk(o[0], o[1]); pk.y = cvtpk(o[2], o[3]); pk.z = cvtpk(o[4], o[5]); pk.w = cvtpk(o[6], o[7]);
    *(u32x4*)(U + row * DFF + c) = pk;
}
DI void ffn_fixup_own(const Frame& F, bf16_t* U, const float* edge, const float* cw, int c) {
    for (int rnd = 0; ; ++rnd) {
        const long L = (long)rnd * F.G + c; if (L >= (T_ALL / 256) * 4) break;
        const int x = (int)(L % 8), off = (int)(L / 8), pm = 8 * (off >> 2) + x;
        if (pm < T_CTX / 256) continue;
        const int k = (pm - T_CTX / 256) & 15;
        for (int it = F.tid; it < 2 * (DFF / 8); it += 512) { const int side = it / (DFF / 8), ch = it % (DFF / 8);
            if (side ? (k != 0) : (k != 15)) ffn_fix_row(U, edge, cw, pm, side, ch * 8); }
    }
    asm volatile("s_waitcnt vmcnt(0)" ::: "memory");
    __syncthreads();
}

struct EpiIn1 {
    static constexpr bool PERM = true; static constexpr bool AROW4 = false;
    bf16_t *XM, *OG; float* gates; const float* bg; const float* rsq; const float* bias;
    DI void operator()(f32x4 (&acc)[2][2][4][2], const Unit& u, int wr, int wc, int fr, int fq) const {
        asm volatile("" : "+v"(fr), "+v"(fq));
        const int region = u.pn >> 2;
        { const int cond = (u.pm >= T_CTX / 256) ? ((u.pm * 256 - T_CTX) >> 12) : 8;
          const float* bp = bias + cond * NIN1P + u.pn * 256 + wc * 64 + fq * 8;
          const f32x4 b00 = *(const f32x4*)bp, b01 = *(const f32x4*)(bp + 4), b10 = *(const f32x4*)(bp + 32), b11 = *(const f32x4*)(bp + 36);
#pragma unroll
          for (int ai = 0; ai < 2; ++ai)
#pragma unroll
              for (int m = 0; m < 4; ++m) { const float rstd = rsqrtf(rsq[u.pm * 256 + ai * 128 + wr * 64 + m * 16 + fr] * (1.f / D) + EPS);
                  acc[ai][0][m][0] = acc[ai][0][m][0] * rstd + b00; acc[ai][0][m][1] = acc[ai][0][m][1] * rstd + b01;
                  acc[ai][1][m][0] = acc[ai][1][m][0] * rstd + b10; acc[ai][1][m][1] = acc[ai][1][m][1] * rstd + b11; } }
#pragma unroll
        for (int ai = 0; ai < 2; ++ai)
#pragma unroll
            for (int m = 0; m < 4; ++m) {
                const size_t row = (size_t)(u.pm * 256 + ai * 128 + wr * 64 + m * 16 + fr);
#pragma unroll
                for (int bj = 0; bj < 2; ++bj) {
                    const int col = (u.pn & 3) * 256 + wc * 64 + bj * 32 + fq * 8;
                    f32x4 v0 = acc[ai][bj][m][0], v1 = acc[ai][bj][m][1];
                    if (region == 0) st_bf16x8(XM + row * D + col, v0, v1);
                    else if (region == 1) {
#pragma unroll
                        for (int i = 0; i < 1; ++i) { v0 = sigmoid4(v0); v1 = sigmoid4(v1); }
                        st_bf16x8(OG + row * D + col, v0, v1);
                    } else if (bj == 0 && wc == 0 && fq < 2) {
                        const f32x4 b0 = *(const f32x4*)(bg + 8 * fq), b1 = *(const f32x4*)(bg + 8 * fq + 4);
                        v0 = v0 + b0; v1 = v1 + b1;
                        if (fq == 0) {
#pragma unroll
                            for (int i = 0; i < 4; ++i) v1[i] = logsigmoid_f(v1[i]);
                        } else {
#pragma unroll
                            for (int i = 0; i < 4; ++i) v1[i] = logsigmoid_f(v1[i]);
                        }
                        float* o = gates + row * 16 + 8 * fq; *(f32x4*)o = v0; *(f32x4*)(o + 4) = v1;
                    }
                }
            }
    }
};

struct QkvOrder {
    const bf16_t *XC, *XM, *W; int nwg, G, c;
    DI void init(const bf16_t* xc, const bf16_t* xm, const bf16_t* w, int G_, int c_) { XC = xc; XM = xm; W = w; nwg = (T_ALL / 256) * 12; G = G_; c = c_; }
    DI bool next(int i, Unit& u) const {
        const long L = (long)i * G + c; if (L >= nwg) return false;
        const int wgid = (int)(L % 8) * (nwg / 8) + (int)(L / 8);
        u.pm = wgid / 12; u.aux = wgid % 12; u.pn = 0; return true;
    }
    DI const char* a_ptr(const Unit& u) const { const int head = u.aux / 3, j = u.aux % 3; return (const char*)((j == 2 ? XM : XC) + (size_t)u.pm * 256 * D + head * 256); }
    DI const char* b_ptr(const Unit& u) const { return (const char*)(W + (size_t)u.aux * 65536); }
};
struct EpiQkv1 {
    static constexpr bool PERM = true; static constexpr bool AROW4 = false;
    bf16_t *Q1, *K1, *V1;
    DI void operator()(f32x4 (&acc)[2][2][4][2], const Unit& u, int wr, int wc, int fr, int fq) const {
        asm volatile("" : "+v"(fr), "+v"(fq));
        const int head = u.aux / 3, j = u.aux % 3;
        bf16_t* O = (j == 0) ? Q1 : (j == 1) ? K1 : V1; const float sc = (j == 1) ? 0.0625f : 1.f;
#pragma unroll
        for (int ai = 0; ai < 2; ++ai)
#pragma unroll
            for (int m = 0; m < 4; ++m) {
                const size_t row = (size_t)(u.pm * 256 + ai * 128 + wr * 64 + m * 16 + fr);
#pragma unroll
                for (int bj = 0; bj < 2; ++bj) st_bf16x8(O + row * D + head * 256 + wc * 64 + bj * 32 + fq * 8, acc[ai][bj][m][0] * sc, acc[ai][bj][m][1] * sc);
            }
    }
};

template <int MAP> DI void tr_item(const float* W, int K, int N, bf16_t* WT, LAS float* scr, int item, int lane) {
    const int nblk = (N + 31) / 32, kb = item / nblk, nb = item % nblk, k0 = 64 * kb, n0 = 32 * nb;
    const int ncol = n0 + (lane & 31);
#pragma unroll 8
    for (int i = 0; i < 32; ++i) { const int kk = 2 * i + (lane >> 5); scr[kk * 33 + (lane & 31)] = (ncol < N) ? W[(size_t)(k0 + kk) * N + ncol] : 0.f; }
    LDS_WAIT(); asm volatile("" ::: "memory");
    int d0 = n0;
    if (MAP == 1) { const int j = (n0 >= DFF) ? n0 - DFF : n0; d0 = (j >> 7) * 256 + ((j >> 5) & 3) * 64 + ((n0 >= DFF) ? 32 : 0) + (j & 31); }
    const int c = lane & 7;
#pragma unroll
    for (int j = 0; j < 4; ++j) { const int n = (lane >> 3) + 8 * j; const LAS float* s = scr + (8 * c) * 33 + n;
        u32x4 o; o.x = cvtpk(s[0 * 33], s[1 * 33]); o.y = cvtpk(s[2 * 33], s[3 * 33]); o.z = cvtpk(s[4 * 33], s[5 * 33]); o.w = cvtpk(s[6 * 33], s[7 * 33]);
        *(u32x4*)(WT + (size_t)(d0 + n) * K + k0 + 8 * c) = o; }
    LDS_WAIT(); asm volatile("" ::: "memory");
}
template <int MAP> DI void tr_matrix(const Frame& F, const float* W, int K, int N, bf16_t* WT, int& rot) {
    LAS float* scr = (LAS float*)(F.lds + 65536 + F.wave * 8704);
    const int nitems = (K / 64) * ((N + 31) / 32);
    int first = F.gw - rot; if (first < 0) first += F.NGW;
    for (int it = first; it < nitems; it += F.NGW) tr_item<MAP>(W, K, N, WT, scr, it, F.lane);
    rot = (rot + nitems) % F.NGW;
}
DI void gemv9_item(const Frame& F, LAS float* coef  , const float* W, int ldw, int N, int n0, const float* addv, float* out, int ldo) {
    LAS float* red = (LAS float*)(F.lds + 36864);
    const int cq = F.lane & 15, kq = F.lane >> 4;
    const int n = n0 + 4 * cq; const bool ok = n < N;
    const float* Wp = W + (ok ? n : 0);
    f32x4 acc[9];
#pragma unroll
    for (int ci = 0; ci < 9; ++ci) acc[ci] = (f32x4){0.f, 0.f, 0.f, 0.f};
    const int kb = F.wave * 128 + kq;
#pragma unroll 8
    for (int k = 0; k < 128; k += 4) { const f32x4 w = *(const f32x4*)(Wp + (size_t)(kb + k) * ldw);
#pragma unroll
        for (int ci = 0; ci < 9; ++ci) acc[ci] += w * coef[ci * 1024 + kb + k]; }
#pragma unroll
    for (int ci = 0; ci < 9; ++ci) {
#pragma unroll
        for (int i = 0; i < 4; ++i) { float v = acc[ci][i]; v += __shfl_xor(v, 16); v += __shfl_xor(v, 32); acc[ci][i] = v; }
        if (kq == 0) *(LAS f32x4*)(red + (F.wave * 9 + ci) * 64 + 4 * cq) = acc[ci]; }
    __syncthreads();
    for (int i = F.tid; i < 9 * 64; i += 512) { float sacc = 0.f;
#pragma unroll
        for (int w = 0; w < 8; ++w) sacc += red[w * 576 + i];
        const int ci = i >> 6, nn = n0 + (i & 63); if (nn < N) out[(size_t)ci * ldo + nn] = sacc + (addv ? addv[nn] : 0.f); }
    __syncthreads();
}
DI void mod_gemv(const Frame& F, const Params& P, float* MOD) {
    if (F.vcu >= 192) return;
    LAS float* sil = (LAS float*)F.lds;
    for (int i = F.tid; i < 9 * 1024; i += 512) { const int ci = i >> 10, k = i & 1023; const float v = (ci < 8) ? P.in[I_C][ci * 1024 + k] : P.in[I_CCTX][k]; sil[i] = silu_f(v); }
    __syncthreads();
    const int item = F.vcu, l = item / 96, n0 = (item % 96) * 64;
    gemv9_item(F, sil, P.in[I_WMOD] + (size_t)l * 1024 * 6144, 6144, 6144, n0, P.in[I_BMOD] + l * 6144, MOD + (size_t)l * 9 * 6144, 6144);
}
DI void bias_gemv(const Frame& F, const Params& P, int first, int stride) {
  for (int item = first; item < 209; item += stride) {
    const float* MOD = (const float*)(P.ws + WS_MOD); float* BIAS = (float*)(P.ws + WS_BIAS);
    const int tbl = item < 88 ? 0 : (item < 121 ? 1 : 2), blk = item < 88 ? item : (item < 121 ? item - 88 : item - 121);
    const float* sh = MOD + (tbl == 0 ? 0 : 9 * 6144) + (tbl == 1 ? 0 : 3072);
    LAS float* coef = (LAS float*)F.lds;
    for (int i = F.tid; i < 9 * 1024; i += 512) coef[i] = sh[(size_t)(i >> 10) * 6144 + (i & 1023)];
    __syncthreads();
    if (tbl == 1) gemv9_item(F, coef, P.in[I_WIN1], NIN1, NIN1, blk * 64, nullptr, BIAS + BIAS_IN1, NIN1P);
    else gemv9_item(F, coef, P.in[I_WUP] + (tbl == 2 ? (size_t)D * 2 * DFF : 0), 2 * DFF, 2 * DFF, blk * 64, nullptr, BIAS + (tbl == 2 ? BIAS_UP1 : BIAS_UP0), 2 * DFF);
  }
}
DI void modulate_rows(const Frame& F, const float* xc, const float* xs, const float* nw, const float* modl, int sh_off, int sc_off, bf16_t* H) {
    for (int grp = F.gw; grp < T_ALL / 4; grp += F.NGW) {
        const int row0 = grp * 4; const bool smp = row0 >= T_CTX; const int cond = smp ? ((row0 - T_CTX) >> 12) : 8;
        const f32x4* xr = (const f32x4*)(smp ? xs + (size_t)(row0 - T_CTX) * D : xc + (size_t)row0 * D) + F.lane;
        f32x4 v[4][4]; float ss[4];
#pragma unroll
        for (int rr = 0; rr < 4; ++rr)
#pragma unroll
            for (int j = 0; j < 4; ++j) v[rr][j] = xr[rr * 256 + 64 * j];
#pragma unroll
        for (int rr = 0; rr < 4; ++rr) { float t = 0.f;
#pragma unroll
            for (int j = 0; j < 4; ++j) t += (v[rr][j].x * v[rr][j].x + v[rr][j].y * v[rr][j].y) + (v[rr][j].z * v[rr][j].z + v[rr][j].w * v[rr][j].w);
            ss[rr] = t; }
#pragma unroll
        for (int o = 1; o < 64; o <<= 1) {
#pragma unroll
            for (int rr = 0; rr < 4; ++rr) ss[rr] += __shfl_xor(ss[rr], o); }
        const float* mp = modl + cond * 6144;
#pragma unroll
        for (int j = 0; j < 4; ++j) { const int c = 4 * (F.lane + 64 * j);
            const f32x4 w = *(const f32x4*)(nw + c), sc = *(const f32x4*)(mp + sc_off + c), sh = *(const f32x4*)(mp + sh_off + c);
            const f32x4 wg = w * (sc + 1.f);
#pragma unroll
            for (int rr = 0; rr < 4; ++rr) { const float rstd = rsqrtf(ss[rr] * (1.f / D) + EPS); const f32x4 y = (v[rr][j] * rstd) * wg + sh;
                u32x2 pk; pk.x = cvtpk(y.x, y.y); pk.y = cvtpk(y.z, y.w); *((u32x2*)(H + (size_t)(row0 + rr) * D) + F.lane + 64 * j) = pk; } }
    }
}
DI void final_norm_rows(const Frame& F, const bf16_t* xb, float* y, const float* w, int row_lo, int row_hi, int wave_idx, int nwaves) {
    for (int grp = row_lo / 4 + wave_idx; grp < row_hi / 4; grp += nwaves) {
        const u32x2* xr = (const u32x2*)(xb + (size_t)grp * 4 * D) + F.lane;
        f32x4* yr = (f32x4*)(y + (size_t)grp * 4 * D) + F.lane;
        f32x4 v[4][4]; float ss[4];
#pragma unroll
        for (int rr = 0; rr < 4; ++rr)
#pragma unroll
            for (int j = 0; j < 4; ++j) { const u32x2 t = xr[rr * 256 + 64 * j];
                v[rr][j] = (f32x4){__uint_as_float(t.x << 16), __uint_as_float(t.x & 0xffff0000u), __uint_as_float(t.y << 16), __uint_as_float(t.y & 0xffff0000u)}; }
#pragma unroll
        for (int rr = 0; rr < 4; ++rr) { float t = 0.f;
#pragma unroll
            for (int j = 0; j < 4; ++j) t += (v[rr][j].x * v[rr][j].x + v[rr][j].y * v[rr][j].y) + (v[rr][j].z * v[rr][j].z + v[rr][j].w * v[rr][j].w);
            ss[rr] = t; }
#pragma unroll
        for (int o = 1; o < 64; o <<= 1) {
#pragma unroll
            for (int rr = 0; rr < 4; ++rr) ss[rr] += __shfl_xor(ss[rr], o); }
#pragma unroll
        for (int j = 0; j < 4; ++j) { const f32x4 ww = *(const f32x4*)(w + 4 * (F.lane + 64 * j));
#pragma unroll
            for (int rr = 0; rr < 4; ++rr) yr[rr * 256 + 64 * j] = (v[rr][j] * rsqrtf(ss[rr] * (1.f / D) + EPS)) * ww; }
    }
}

DI bool seq_first(int row) { return row < T_CTX ? ((row & 255) == 0) : (((row - T_CTX) & 4095) == 0); }
DI bool seq_last(int row) { return row < T_CTX ? ((row & 255) == 255) : (((row - T_CTX) & 4095) == 4095); }
DI void unpack8(const u32x4& w, float (&f)[8]) { f[0] = bflo(w.x); f[1] = bfhi(w.x); f[2] = bflo(w.y); f[3] = bfhi(w.y); f[4] = bflo(w.z); f[5] = bfhi(w.z); f[6] = bflo(w.w); f[7] = bfhi(w.w); }

DI void mconv_rows(const Frame& F, const bf16_t* XM, bf16_t* XC, const float* cw, const float* cb) {
    for (int grp = F.gw; grp < T_ALL / 4; grp += F.NGW) {
        const int row0 = grp * 4; const bool hp = !seq_first(row0), hn = !seq_last(row0 + 3);
        const u32x4 z = {0u, 0u, 0u, 0u};
#pragma unroll
        for (int j = 0; j < 2; ++j) {
            const int c = (F.lane + 64 * j) * 8;
            const bf16_t* ar = XM + (size_t)row0 * D + c;
            u32x4 a[6];
            a[0] = hp ? *(const u32x4*)(ar - D) : z; a[5] = hn ? *(const u32x4*)(ar + 4 * D) : z;
#pragma unroll
            for (int rr = 0; rr < 4; ++rr) a[1 + rr] = *(const u32x4*)(ar + rr * D);
            float w0[8], w1[8], w2[8], bb[8];
#pragma unroll
            for (int i = 0; i < 8; i += 4) { *(f32x4*)(w0 + i) = *(const f32x4*)(cw + c + i); *(f32x4*)(w1 + i) = *(const f32x4*)(cw + D + c + i); *(f32x4*)(w2 + i) = *(const f32x4*)(cw + 2 * D + c + i); *(f32x4*)(bb + i) = *(const f32x4*)(cb + c + i); }
            float f[6][8];
#pragma unroll
            for (int q = 0; q < 6; ++q) unpack8(a[q], f[q]);
#pragma unroll
            for (int rr = 0; rr < 4; ++rr) { float o[8];
#pragma unroll
                for (int i = 0; i < 8; ++i) o[i] = silu_f(w0[i] * f[rr][i] + w1[i] * f[rr + 1][i] + w2[i] * f[rr + 2][i] + bb[i]);
                u32x4 w; w.x = cvtpk(o[0], o[1]); w.y = cvtpk(o[2], o[3]); w.z = cvtpk(o[4], o[5]); w.w = cvtpk(o[6], o[7]);
                *(u32x4*)(XC + (size_t)(row0 + rr) * D + c) = w; }
        }
    }
}
DI void mpost_rows(const Frame& F, const bf16_t* HF, const bf16_t* HB, const bf16_t* OG, const bf16_t* XC, const float* hnw, const float* skip, bf16_t* Y) {
    for (int grp = F.gw; grp < T_ALL / 4; grp += F.NGW) {
        const size_t rb0 = (size_t)grp * 4 * D;
#pragma unroll
        for (int hd = 0; hd < 4; ++hd) {
            const int c = hd * 256 + 4 * F.lane;
            u32x2 a[4], b[4], g[4], x[4]; float hs[4][4], ss[4];
#pragma unroll
            for (int rr = 0; rr < 4; ++rr) { const size_t o = rb0 + (size_t)rr * D + c; a[rr] = *(const u32x2*)(HF + o); b[rr] = *(const u32x2*)(HB + o); g[rr] = *(const u32x2*)(OG + o); x[rr] = *(const u32x2*)(XC + o); }
#pragma unroll
            for (int rr = 0; rr < 4; ++rr) { hs[rr][0] = bflo(a[rr].x) + bflo(b[rr].x); hs[rr][1] = bfhi(a[rr].x) + bfhi(b[rr].x); hs[rr][2] = bflo(a[rr].y) + bflo(b[rr].y); hs[rr][3] = bfhi(a[rr].y) + bfhi(b[rr].y);
                ss[rr] = (hs[rr][0] * hs[rr][0] + hs[rr][1] * hs[rr][1]) + (hs[rr][2] * hs[rr][2] + hs[rr][3] * hs[rr][3]); }
#pragma unroll
            for (int o = 1; o < 64; o <<= 1) {
#pragma unroll
                for (int rr = 0; rr < 4; ++rr) ss[rr] += __shfl_xor(ss[rr], o); }
            const f32x4 w = *(const f32x4*)(hnw + c), sk = *(const f32x4*)(skip + c);
#pragma unroll
            for (int rr = 0; rr < 4; ++rr) { const float rstd = rsqrtf(ss[rr] * (1.f / 256.f) + EPS);
                const float og[4] = {bflo(g[rr].x), bfhi(g[rr].x), bflo(g[rr].y), bfhi(g[rr].y)}, xc[4] = {bflo(x[rr].x), bfhi(x[rr].x), bflo(x[rr].y), bfhi(x[rr].y)};
                float y[4];
#pragma unroll
                for (int i = 0; i < 4; ++i) y[i] = og[i] * (hs[rr][i] * rstd * w[i] + sk[i] * xc[i]);
                u32x2 pk; pk.x = cvtpk(y[0], y[1]); pk.y = cvtpk(y[2], y[3]);
                *(u32x2*)(Y + rb0 + (size_t)rr * D + c) = pk; }
        }
    }
}
DI void p9_weights(const Frame& F, const Params& P, int& rot) {
    unsigned char* ws = P.ws;
    tr_matrix<0>(F, P.in[I_WIN1], D, NIN1, (bf16_t*)(ws + WS_WIN1), rot);
    tr_matrix<0>(F, P.in[I_WOUT1], D, D, (bf16_t*)(ws + WS_WOUT1), rot);
#pragma unroll 1
    for (int hj = 0; hj < 12; ++hj) { const int head = hj / 3, j = hj % 3; const float* W = P.in[j == 0 ? I_WQ : j == 1 ? I_WK : I_WV] + (size_t)head * 65536;
        tr_matrix<0>(F, W, 256, 256, (bf16_t*)(ws + WS_WQKV1) + (size_t)hj * 65536, rot); }
}
DI void p16_weights(const Frame& F, const Params& P) {
    unsigned char* ws = P.ws; int rot = 0;
    tr_matrix<1>(F, P.in[I_WUP] + (size_t)D * 2 * DFF, D, 2 * DFF, (bf16_t*)(ws + WS_WUP1), rot);
    tr_matrix<0>(F, P.in[I_WDOWN] + (size_t)DFF * D, DFF, D, (bf16_t*)(ws + WS_WDOWN1), rot);
}

DI void p0_prologue(const Frame& F, const Params& P) {
    unsigned char* ws = P.ws;
    mod_gemv(F, P, (float*)(ws + WS_MOD));
    int rot = 192 * 8;
    tr_matrix<0>(F, P.in[I_WIN0], D, NIN0, (bf16_t*)(ws + WS_WIN0), rot);
    tr_matrix<0>(F, P.in[I_WOUT0], D, D, (bf16_t*)(ws + WS_WOUT0), rot);
    tr_matrix<1>(F, P.in[I_WUP], D, 2 * DFF, (bf16_t*)(ws + WS_WUP), rot);
    tr_matrix<0>(F, P.in[I_WDOWN], DFF, D, (bf16_t*)(ws + WS_WDOWN), rot);
    p9_weights(F, P, rot);
    const int gt = F.gw * 64 + F.lane, NGT = F.NGW * 64;
    for (int i = gt; i < 8 * PAST * 64; i += NGT) {
        const int b = i / (PAST * 64), rem = i % (PAST * 64);
        const size_t src = (size_t)i * 8, dst = ((size_t)b * LKS) * 512 + (size_t)rem * 8;
        const f32x4 k0 = *(const f32x4*)(P.in[I_CK] + src), k1 = *(const f32x4*)(P.in[I_CK] + src + 4);
        const f32x4 v0 = *(const f32x4*)(P.in[I_CV] + src), v1 = *(const f32x4*)(P.in[I_CV] + src + 4);
        st_bf16x8((bf16_t*)(ws + WS_KS) + dst, k0, k1); st_bf16x8((bf16_t*)(ws + WS_VS) + dst, v0, v1);
    }
    if (F.vcu == 255) {
        float* rope = (float*)(ws + WS_ROPE);
        for (int i = F.tid; i < 1024; i += 512) { const int coord = i >> 4, f = i & 15; const float inv = exp2f(-(float)f * (13.287712379549449f / 16.f)); const float a = (float)coord * inv;
            rope[i] = __cosf(a); rope[1024 + i] = __sinf(a); }
        if (F.wave == 0) {
            const float d1 = wave_sum(P.in[I_LQ1][F.lane] * P.in[I_LK1][F.lane]), d2 = wave_sum(P.in[I_LQ2][F.lane] * P.in[I_LK2][F.lane]);
            if (F.lane == 0) *(float*)(ws + WS_LAM) = __expf(d1) - __expf(d2) + LAM_INIT;
        }
    }
}
DI void gmlp_item(const Frame& F, const Params& P, int chunk, int g) {
    unsigned char* ws = P.ws;
    constexpr int WSTR = 272, GSTR = 320;
    LAS unsigned char* WT = F.lds; LAS unsigned char* GT = F.lds + 128 * WSTR;
    const int R0 = chunk * 128;
    const float* rowsq = (const float*)(ws + WS_ROWSQ);
    const float* Wsp = P.in[I_WSP] + (size_t)g * 16384;
    const bf16_t* GV = (const bf16_t*)(ws + WS_GV); const bf16_t* GU = (const bf16_t*)(ws + WS_GU);
#pragma unroll
    for (int j = 0; j < 8; ++j) { const int idx = F.tid + 512 * j, t = idx >> 5, s4 = (idx & 31) * 4;
        const f32x4 w = *(const f32x4*)(Wsp + t * 128 + s4); const f32x4 q = *(const f32x4*)(rowsq + R0 + s4);
        u32x2 pk; pk.x = cvtpk(w.x * rsqrtf(q.x * (1.f / 512.f) + EPS), w.y * rsqrtf(q.y * (1.f / 512.f) + EPS)); pk.y = cvtpk(w.z * rsqrtf(q.z * (1.f / 512.f) + EPS), w.w * rsqrtf(q.w * (1.f / 512.f) + EPS));
        *(LAS u32x2*)(WT + t * WSTR + s4 * 2) = pk; }
#pragma unroll
    for (int j = 0; j < 4; ++j) { const int idx = F.tid + 512 * j, s = idx >> 4, ch = idx & 15;
        *(LAS u32x4*)(GT + s * GSTR + ch * 16) = *(const u32x4*)(GV + (size_t)(R0 + s) * 512 + g * 128 + ch * 8); }
    __syncthreads();
    const int lane = F.lane, r = lane & 31, h = lane >> 5, g16 = (lane >> 4) & 1, q4 = (lane & 15) >> 2, p4 = lane & 3, tb = F.wave & 3, chh = F.wave >> 2;
    f32x16 acc[2]; acc[0] = f32x16{}; acc[1] = f32x16{};
#pragma unroll
    for (int ks = 0; ks < 8; ++ks) {
        const bf16x8 af = *(const LAS bf16x8*)(WT + (32 * tb + r) * WSTR + ks * 32 + h * 16);
#pragma unroll
        for (int ct = 0; ct < 2; ++ct) {
            LAS const unsigned char* bp = GT + (16 * ks + 8 * h + q4) * GSTR + (64 * chh + 32 * ct + 16 * g16 + 4 * p4) * 2;
            const bf16x8 bfr = cat8(ldtr(bp), ldtr(bp + 4 * GSTR));
            acc[ct] = MFMA32(bfr, af, acc[ct]);
        }
    }
    const float* gnw = P.in[I_GNW] + g * 128; const float* bsp = P.in[I_BSP] + g * 128;
    bf16_t* MIX = (bf16_t*)(ws + WS_MIX);
    { const int t = 32 * tb + r; const float bt = bsp[t];
      const size_t gro = (size_t)(R0 + t) * 512 + g * 128, mro = (size_t)(R0 + t) * D + 512 + g * 128;
#pragma unroll
      for (int ct = 0; ct < 2; ++ct)
#pragma unroll
          for (int q = 0; q < 4; ++q) { const int c = 64 * chh + 32 * ct + 8 * q + 4 * h;
              const f32x4 gw = *(const f32x4*)(gnw + c); const u32x2 uu = *(const u32x2*)(GU + gro + c);
              const float v0 = bflo(uu.x) * (acc[ct][4 * q] * gw.x + bt), v1 = bfhi(uu.x) * (acc[ct][4 * q + 1] * gw.y + bt), v2 = bflo(uu.y) * (acc[ct][4 * q + 2] * gw.z + bt), v3 = bfhi(uu.y) * (acc[ct][4 * q + 3] * gw.w + bt);
              u32x2 pk; pk.x = cvtpk(v0, v1); pk.y = cvtpk(v2, v3); *(u32x2*)(MIX + mro + c) = pk; } }
    __syncthreads();
}

constexpr int AK_STR = 144, AV_STR = 320, AK_BYTES = 64 * AK_STR, AV_BYTES = 64 * AV_STR, AKB = 0, AVB = 2 * AK_BYTES, AWSF = AVB + 2 * AV_BYTES, AQ_OFF = AWSF + 2048, AQ_WAVE = 32 * AK_STR;
constexpr float ATT_THR = 8.f;
DI void attn_unit(const Frame& F, const Params& P, const bf16_t* Qb  , const bf16_t* Kb, const bf16_t* Vb, int Lk, bf16_t* Ob  , int hd) {
    int l_tid0 = F.tid; asm volatile("" : "+v"(l_tid0));
    const int tid = l_tid0, lane = tid & 63, wid = F.wave, r = lane & 31, h = lane >> 5, g16 = (lane >> 4) & 1, q4 = (lane & 15) >> 2, p4 = lane & 3;
    LAS unsigned char* lds = F.lds;
    LAS float* wsf = (LAS float*)(lds + AWSF) + wid * 64;
    float* scr = (float*)(P.ws + WS_ASCR) + (size_t)F.vcu * 32768 + wid * 4096;
    const int NT = Lk / 64;
    f32x16 o[4];
#pragma unroll 1
    for (int mp = 0; mp < 2; ++mp) {
        int l_tid1 = tid; asm volatile("" : "+v"(l_tid1));
        const int tid = l_tid1, lane = tid & 63, r = lane & 31, h = lane >> 5, g16 = (lane >> 4) & 1, q4 = (lane & 15) >> 2, p4 = lane & 3;
        const bf16_t* Qw = Qb + (size_t)(wid * 32 + r) * 512 + mp * 64 + 8 * h;
        LAS unsigned char* qlds = lds + AQ_OFF + wid * AQ_WAVE + r * AK_STR + h * 16;
        bf16x8 qreg[4];
#pragma unroll
        for (int ks = 0; ks < 4; ++ks) qreg[ks] = *(const bf16x8*)(Qw + 16 * ks);
        const bf16_t* Kg = Kb + mp * 64;
        const unsigned kvo = (unsigned)((tid >> 3) * 512 + (tid & 7) * 8), vvo = (unsigned)((tid >> 4) * 512 + (tid & 15) * 8);
        const int kdst = (tid >> 3) * AK_STR + (tid & 7) * 16, vdst0 = (tid >> 4) * AV_STR + (tid & 15) * 16, vdst1 = vdst0 + 32 * AV_STR;
        u32x4 k2r = {};
        { const u32x4 k0 = *(const u32x4*)(Kg + kvo), v0 = *(const u32x4*)(Vb + vvo), v1 = *(const u32x4*)(Vb + 32 * 512 + vvo);
          *(LAS u32x4*)(lds + AKB + kdst) = k0; *(LAS u32x4*)(lds + AVB + vdst0) = v0; *(LAS u32x4*)(lds + AVB + vdst1) = v1;
          if (NT > 1) { const u32x4 k1 = *(const u32x4*)(Kg + (size_t)64 * 512 + kvo); *(LAS u32x4*)(lds + AKB + AK_BYTES + kdst) = k1; }
          if (NT > 2) k2r = *(const u32x4*)(Kg + (size_t)128 * 512 + kvo); }
        __syncthreads();
#pragma unroll
        for (int e = 0; e < 4; ++e) o[e] = f32x16{};
        float mhat = 0.f, lsum = 0.f;
        const f32x16 z16 = f32x16{};
        bf16x8 pa00, pa01, pa10, pa11;
        f32x16 p0, p1;
        bf16x8 kf[8];
#define ATT_KLD(KBUF) do { _Pragma("unroll") for (int ks = 0; ks < 4; ++ks) { \
                kf[ks] = *(const LAS bf16x8*)(lds + (KBUF) + r * AK_STR + ks * 32 + h * 16); \
                kf[4 + ks] = *(const LAS bf16x8*)(lds + (KBUF) + (32 + r) * AK_STR + ks * 32 + h * 16); } } while (0)
#define ATT_QKM() do { __builtin_amdgcn_sched_barrier(0); \
            p0 = MFMA32(kf[0], qreg[0], z16); p1 = MFMA32(kf[4], qreg[0], z16); \
            _Pragma("unroll") for (int ks = 1; ks < 4; ++ks) { p0 = MFMA32(kf[ks], qreg[ks], p0); p1 = MFMA32(kf[4 + ks], qreg[ks], p1); } \
            asm volatile("s_nop 15\n\ts_nop 7" : "+v"(p0), "+v"(p1));      \
        } while (0)
#define ATT_MAX(RM) do { float ra_ = max3f(p0[0], p0[1], p1[0]), rb_ = max3f(p0[2], p0[3], p1[1]); ra_ = max3f(ra_, p1[2], p1[3]); \
            _Pragma("unroll") for (int i = 4; i < 16; i += 4) { ra_ = max3f(ra_, p0[i], p0[i + 1]); rb_ = max3f(rb_, p0[i + 2], p0[i + 3]); ra_ = max3f(ra_, p1[i], p1[i + 1]); rb_ = max3f(rb_, p1[i + 2], p1[i + 3]); } \
            RM = max2f(ra_, rb_); RM = xhalf_max(RM); } while (0)
#define ATT_EXP() do { float sacc = 0.f; \
            f32x2 sa2_ = {0.f, 0.f}, sb2_ = {0.f, 0.f}; const f32x2 nm2_ = {-mhat, -mhat}; \
            _Pragma("unroll") for (int i = 0; i < 16; i += 2) { const f32x2 a2_ = (f32x2){p0[i], p0[i + 1]} + nm2_, b2_ = (f32x2){p1[i], p1[i + 1]} + nm2_; \
                p0[i] = __builtin_amdgcn_exp2f(a2_.x); p0[i + 1] = __builtin_amdgcn_exp2f(a2_.y); p1[i] = __builtin_amdgcn_exp2f(b2_.x); p1[i + 1] = __builtin_amdgcn_exp2f(b2_.y); \
                sa2_ += (f32x2){p0[i], p0[i + 1]}; sb2_ += (f32x2){p1[i], p1[i + 1]}; } \
            sa2_ += sb2_; sacc = sa2_.x + sa2_.y; \
            lsum += sacc; } while (0)
#define ATT_VLD(DST, VBUF, E) do { LAS const unsigned char* ve_ = lds + (VBUF) + (4 * h + q4) * AV_STR + (16 * g16 + 4 * p4) * 2 + (E) * 64; \
            DST[0] = cat8(ldtr(ve_), ldtr(ve_ + 8 * AV_STR)); DST[1] = cat8(ldtr(ve_ + 16 * AV_STR), ldtr(ve_ + 24 * AV_STR)); \
            DST[2] = cat8(ldtr(ve_ + 32 * AV_STR), ldtr(ve_ + 40 * AV_STR)); DST[3] = cat8(ldtr(ve_ + 48 * AV_STR), ldtr(ve_ + 56 * AV_STR)); } while (0)
#define ATT_PV(SRC, E) do { o[E] = MFMA32(pa00, SRC[0], o[E]); o[E] = MFMA32(pa01, SRC[1], o[E]); o[E] = MFMA32(pa10, SRC[2], o[E]); o[E] = MFMA32(pa11, SRC[3], o[E]); } while (0)
        ATT_KLD(AKB); ATT_QKM();
        { float rm; ATT_MAX(rm); mhat = rm;
          ATT_EXP(); pa00 = pack8(p0, 0); pa01 = pack8(p0, 1); pa10 = pack8(p1, 0); pa11 = pack8(p1, 1); }
        if (NT > 1) ATT_KLD(AKB + AK_BYTES);
        __syncthreads();
        if (NT > 2) *(LAS u32x4*)(lds + AKB + kdst) = k2r;
        __syncthreads();
#pragma unroll 1
        for (int t = 0; t < NT; ++t) {
            const int vcur = AVB + (t & 1) * AV_BYTES, vnxt = AVB + AV_BYTES - (t & 1) * AV_BYTES, knxt = AKB + AK_BYTES - (t & 1) * AK_BYTES, kfar = AKB + (t & 1) * AK_BYTES;
            const bool m1 = (t + 1 < NT), m2 = (t + 2 < NT), m3 = (t + 3 < NT);
            u32x4 kr = {}, v0 = {}, v1 = {};
            if (m3) kr = *(const u32x4*)(Kg + (size_t)(t + 3) * 64 * 512 + kvo);
            if (m1) { const size_t go = (size_t)(t + 1) * 64 * 512; v0 = *(const u32x4*)(Vb + go + vvo); v1 = *(const u32x4*)(Vb + go + 32 * 512 + vvo); }
            bf16x8 va_[4], vb_[4]; bool resc = false;
            ATT_VLD(va_, vcur, 0);
            if (m1) {
                ATT_QKM();
                float rm; ATT_MAX(rm); rm -= mhat;
                if (__any(rm > ATT_THR)) {
                    const float dl = fmaxf(rm, 0.f); mhat += dl;
                    const float f = __builtin_amdgcn_exp2f(-dl); lsum *= f; if (h == 0) wsf[r] = f; resc = true; }
                ATT_VLD(vb_, vcur, 1);
                __builtin_amdgcn_s_setprio(1);
                ATT_PV(va_, 0); ATT_VLD(va_, vcur, 2); ATT_PV(vb_, 1); ATT_VLD(vb_, vcur, 3); ATT_PV(va_, 2); ATT_PV(vb_, 3);
                ATT_EXP();
                bf16x8 n00 = pack8(p0, 0), n01 = pack8(p0, 1), n10 = pack8(p1, 0), n11 = pack8(p1, 1);
                asm volatile("" : "+v"(n00), "+v"(n01), "+v"(n10), "+v"(n11)); __builtin_amdgcn_s_setprio(0);
#pragma unroll
                for (int i = 0; i < 16; ++i) { __builtin_amdgcn_sched_group_barrier(0x008, 1, 0); __builtin_amdgcn_sched_group_barrier(0x002, 6, 0); }
                if (resc) {
#pragma unroll
                    for (int reg = 0; reg < 16; ++reg) { const float fr_ = wsf[crow(reg, h)];
#pragma unroll
                        for (int e = 0; e < 4; ++e) o[e][reg] *= fr_; } }
                pa00 = n00; pa01 = n01; pa10 = n10; pa11 = n11;
            } else {
                ATT_VLD(vb_, vcur, 1); ATT_PV(va_, 0); ATT_VLD(va_, vcur, 2); ATT_PV(vb_, 1); ATT_VLD(vb_, vcur, 3); ATT_PV(va_, 2); ATT_PV(vb_, 3);
            }
            if (m2) ATT_KLD(kfar);
            if (m3) *(LAS u32x4*)(lds + knxt + kdst) = kr;
            if (m1) { *(LAS u32x4*)(lds + vnxt + vdst0) = v0; *(LAS u32x4*)(lds + vnxt + vdst1) = v1; }
            __syncthreads();
        }
#undef ATT_KLD
#undef ATT_QKM
#undef ATT_MAX
#undef ATT_EXP
#undef ATT_VLD
#undef ATT_PV
        lsum = xhalf_sum(lsum);
        { int l_lane = lane; asm volatile("" : "+v"(l_lane));
        const int lane = l_lane, r = lane & 31, h = lane >> 5;
        if (h == 0) wsf[32 + r] = 1.f / lsum;
        if (mp == 0) {
#pragma unroll
            for (int reg = 0; reg < 16; ++reg) { const float li = wsf[32 + crow(reg, h)];
#pragma unroll
                for (int e = 0; e < 4; ++e) scr[(e * 16 + reg) * 64 + lane] = o[e][reg] * li; }
        } else {
            const float* sw = P.in[I_SUBLN];
            const float lam = *(const float*)(P.ws + WS_LAM);
            float swv[4];
#pragma unroll
            for (int e = 0; e < 4; ++e) swv[e] = sw[32 * e + r];
#pragma unroll
            for (int reg = 0; reg < 16; ++reg) { const float li = wsf[32 + crow(reg, h)];
                float v[4], ss = 0.f;
#pragma unroll
                for (int e = 0; e < 4; ++e) { v[e] = scr[(e * 16 + reg) * 64 + lane] - lam * (o[e][reg] * li); ss += v[e] * v[e]; }
#pragma unroll
                for (int of = 1; of < 32; of <<= 1) ss += __shfl_xor(ss, of);
                const float rstd = rsqrtf(ss * (1.f / 128.f) + EPS) * (1.f - LAM_INIT);
                bf16_t* op = Ob + (size_t)(wid * 32 + crow(reg, h)) * D + hd * 128 + r;
#pragma unroll
                for (int e = 0; e < 4; ++e) op[32 * e] = (bf16_t)(cvtpk(v[e] * rstd * swv[e], 0.f) & 0xffffu); }
        }
        }
        __syncthreads();
    }
}

DI void phase_mix0(const Frame& F, const Params& P) {
    unsigned char* ws = P.ws;
    if (F.G == 256) { if (F.vcu >= 64) for (int it = F.vcu - 64; it < (T_ALL / 128) * 4; it += 192) gmlp_item(F, P, it >> 2, it & 3); }
    else for (int it = F.vcu; it < (T_ALL / 128) * 4; it += F.G) gmlp_item(F, P, it >> 2, it & 3);
    const bf16_t* Q = (const bf16_t*)(ws + WS_Q); bf16_t* MIX = (bf16_t*)(ws + WS_MIX);
#pragma unroll 1
    for (int u = F.vcu; u < 512 + 64; u += F.G) {
        const bool smp = u < 512; const int uc = u - 512;
        const int hd = smp ? ((u >> 4) & 3) : (uc & 3), b = u >> 6;
        const size_t qrow = smp ? (size_t)T_CTX + (size_t)b * SEQ_S + (u & 15) * 256 : (size_t)(uc >> 2) * 256;
        const bf16_t* Kb = smp ? (const bf16_t*)(ws + WS_KS) + (size_t)b * LKS * 512 : (const bf16_t*)(ws + WS_KC) + qrow * 512;
        const bf16_t* Vb = smp ? (const bf16_t*)(ws + WS_VS) + (size_t)b * LKS * 512 : (const bf16_t*)(ws + WS_VC) + qrow * 512;
        attn_unit(F, P, Q + qrow * 512 + hd * 128, Kb + hd * 128, Vb + hd * 128, smp ? LKS : 256, MIX + qrow * D, hd);
    }
}

constexpr int MK_STR = 528, MV_STR = 192;
constexpr int ML_KT = 0, ML_VT = 128 * MK_STR, ML_VW = ML_VT + 128 * MV_STR, ML_CT = ML_VW + 128 * MV_STR, ML_NB = ML_CT + 64 * MK_STR, ML_UV = ML_NB + 512, ML_MV = ML_UV + 512, ML_WI = ML_MV + 512,
              ML_CL = ML_WI + 512, ML_WSB = ML_CL + 512, ML_DEN = ML_WSB + 256, ML_QN = ML_DEN + 1024, ML_NF = ML_QN + 1024, ML_ZR = ML_NF + 1024, ML_END = ML_ZR + 512;
static_assert(ML_END <= MISC_OFF, "mLSTM LDS map");
template <int CTRL, int ROWMASK> DI float dpp_id(float idv, float src) { return __int_as_float(__builtin_amdgcn_update_dpp(__float_as_int(idv), __float_as_int(src), CTRL, ROWMASK, 0xf, false)); }
DI float scan_sum(float v, int lane) {
    v += dpp_id<0x111, 0xf>(0.f, v); v += dpp_id<0x112, 0xf>(0.f, v); v += dpp_id<0x114, 0xf>(0.f, v); v += dpp_id<0x118, 0xf>(0.f, v);
    v += dpp_id<0x142, 0xa>(0.f, v);
    v += dpp_id<0x143, 0xc>(0.f, v);
    return v;
}
DI float scan_max(float v, int lane) {
    const float ninf = -__builtin_inff();
    v = fmaxf(v, dpp_id<0x111, 0xf>(ninf, v)); v = fmaxf(v, dpp_id<0x112, 0xf>(ninf, v)); v = fmaxf(v, dpp_id<0x114, 0xf>(ninf, v)); v = fmaxf(v, dpp_id<0x118, 0xf>(ninf, v));
    v = fmaxf(v, dpp_id<0x142, 0xa>(ninf, v));
    v = fmaxf(v, dpp_id<0x143, 0xc>(ninf, v));
    return v;
}
template <int TB> DI void mlstm_main(LAS unsigned char* lds, bf16x8 (&qf)[16], const bf16_t* qrow_hi  , int eh, int wid, int lane, bf16_t* hp  , int hstride  ) {
    const int r = lane & 31, h = lane >> 5, g16 = (lane >> 4) & 1, q4 = (lane & 15) >> 2, p4 = lane & 3;
    LAS float* UV = (LAS float*)(lds + ML_UV); LAS float* MV = (LAS float*)(lds + ML_MV); LAS float* WI = (LAS float*)(lds + ML_WI); LAS float* CL = (LAS float*)(lds + ML_CL);
    LAS float* DEN = (LAS float*)(lds + ML_DEN) + wid * 32; LAS float* QN = (LAS float*)(lds + ML_QN) + wid * 32;
    const bf16x8 zero8 = {0, 0, 0, 0, 0, 0, 0, 0};
#pragma unroll
    for (int ks = 8; ks < 16; ++ks) qf[ks] = *(const bf16x8*)(qrow_hi + 16 * (ks - 8));
    f32x16 sT[TB + 1], ni = f32x16{}, qn = f32x16{};
#pragma unroll
    for (int st = 0; st <= TB; ++st) sT[st] = f32x16{};
    LAS const unsigned char* kb = lds + ML_KT + r * MK_STR + h * 16;
    LAS const unsigned char* cb = lds + ML_CT + (32 * eh + r) * MK_STR + h * 16;
    LAS const unsigned char* nb = lds + ((r == 0) ? ML_NB : ML_ZR) + h * 16;
    const float Mt = MV[32 * TB + r]; float rs = 0.f;
#define ML_SMMA(ST) do { _Pragma("unroll") for (int ks = 0; ks < 16; ++ks) { const bf16x8 kf = *(const LAS bf16x8*)(kb + (ST) * 32 * MK_STR + ks * 32); sT[ST] = MFMA32(kf, qf[ks], sT[ST]); } } while (0)
#define ML_PBLK(ST) do { _Pragma("unroll") for (int g = 0; g < 4; ++g) { \
            const f32x4 u4 = *(const LAS f32x4*)(UV + 32 * (ST) + 8 * g + 4 * h); \
            _Pragma("unroll") for (int i = 0; i < 4; ++i) { \
                float v = sT[ST][4 * g + i] * __builtin_amdgcn_exp2f(fminf(u4[i] - Mt, 0.f)); \
                if ((ST) == TB) v = (8 * g + 4 * h + i <= r) ? v : 0.f; \
                sT[ST][4 * g + i] = v; rs += v; } } } while (0)
    ML_SMMA(0);
    __builtin_amdgcn_sched_barrier(0);
#pragma unroll
    for (int st = 1; st <= TB; ++st) {
        ML_SMMA(st); ML_PBLK(st - 1);
#pragma unroll
        for (int i = 0; i < 16; ++i) { __builtin_amdgcn_sched_group_barrier(0x008, 1, 0); __builtin_amdgcn_sched_group_barrier(0x002, 7, 0); }
        __builtin_amdgcn_sched_barrier(0);
    }
#pragma unroll
    for (int ks = 0; ks < 16; ++ks) {
        const bf16x8 cf = *(const LAS bf16x8*)(cb + ks * 32);
        ni = MFMA32(qf[ks], cf, ni);
        const bf16x8 nf = *(const LAS bf16x8*)(nb + ks * 32);
        qn = MFMA32(qf[ks], nf, qn);
    }
    ML_PBLK(TB);
#pragma unroll
    for (int i = 0; i < 32; ++i) { __builtin_amdgcn_sched_group_barrier(0x008, 1, 0); __builtin_amdgcn_sched_group_barrier(0x002, 4, 0); }
#undef ML_SMMA
#undef ML_PBLK
    __builtin_amdgcn_sched_barrier(0);
    rs = xhalf_sum(rs);
    if (h == 0) DEN[r] = rs;
    if (r == 0) {
#pragma unroll
        for (int g = 0; g < 4; ++g) { f32x4 t4 = {qn[4 * g], qn[4 * g + 1], qn[4 * g + 2], qn[4 * g + 3]}; *(LAS f32x4*)(QN + 8 * g + 4 * h) = t4; } }
    f32x16 nA = f32x16{};
    LAS const unsigned char* vb = lds + ML_VT + (4 * h + q4) * MV_STR + (32 * eh + 16 * g16 + 4 * p4) * 2;
#pragma unroll
    for (int st = 0; st <= TB; ++st) {
#pragma unroll
        for (int s2 = 0; s2 < 2; ++s2) { LAS const unsigned char* vp = vb + (32 * st + 16 * s2) * MV_STR;
            nA = MFMA32(pack8(sT[st], s2), cat8(ldtr(vp), ldtr(vp + 8 * MV_STR)), nA); } }
    __builtin_amdgcn_sched_barrier(0);
    bf16_t* hl = hp + (long)hstride * (4 * h) + r;
#pragma unroll
    for (int g = 0; g < 4; ++g) {
        const f32x4 wi4 = *(const LAS f32x4*)(WI + 32 * TB + 8 * g + 4 * h), cl4 = *(const LAS f32x4*)(CL + 32 * TB + 8 * g + 4 * h);
        const f32x4 de4 = *(const LAS f32x4*)(DEN + 8 * g + 4 * h), qn4 = *(const LAS f32x4*)(QN + 8 * g + 4 * h);
#pragma unroll
        for (int i = 0; i < 4; ++i) {
            const float den = de4[i] + wi4[i] * qn4[i];
            const float hv = (nA[4 * g + i] + wi4[i] * ni[4 * g + i]) * __builtin_amdgcn_rcpf(fmaxf(fabsf(den), cl4[i]));
            hl[(long)hstride * (8 * g + i)] = (bf16_t)(cvtpk(hv, 0.f) & 0xffffu); }
        __builtin_amdgcn_sched_barrier(0); }
}
DI void mlstm_item(const Frame& F, const Params& P, int R0, int L, int sidx  , bool ctx, int hd, int dir, int sl) {
    unsigned char* ws = P.ws;
    const int wid = F.wave, tb = (wid < 4) ? wid : 7 - wid, eh = wid >> 2;
    LAS unsigned char* lds = F.lds;
    LAS float* UV = (LAS float*)(lds + ML_UV); LAS float* MV = (LAS float*)(lds + ML_MV); LAS float* WI = (LAS float*)(lds + ML_WI); LAS float* CL = (LAS float*)(lds + ML_CL);
    LAS bf16_t* WSB = (LAS bf16_t*)(lds + ML_WSB); LAS bf16_t* NB = (LAS bf16_t*)(lds + ML_NB);
    LAS float* DEN = (LAS float*)(lds + ML_DEN) + wid * 32; LAS float* QN = (LAS float*)(lds + ML_QN) + wid * 32; LAS float* NF = (LAS float*)(lds + ML_NF);
    const bf16_t* Q1 = (const bf16_t*)(ws + WS_Q1); const bf16_t* K1 = (const bf16_t*)(ws + WS_K1); const bf16_t* V1 = (const bf16_t*)(ws + WS_V1);
    const float* GATES = (const float*)(ws + WS_GATES);
    bf16_t* HO = (bf16_t*)(ws + (dir ? WS_HB : WS_HF));
    const int nc = L / 128;
    f32x16 Cacc[2]; float m_prev = 0.f;
    {
        int l_tid0 = F.tid; asm volatile("" : "+v"(l_tid0));
        const int tid = l_tid0, lane = tid & 63, r = lane & 31, h = lane >> 5;
#pragma unroll
        for (int dt = 0; dt < 2; ++dt) Cacc[dt] = f32x16{};
        if (!ctx) {
            const size_t sbase = ((size_t)(sidx * 2 + dir) * 4 + hd);
            const float* C0 = P.in[I_SC] + sbase * 65536;
#pragma unroll
            for (int dt = 0; dt < 2; ++dt)
#pragma unroll
                for (int reg = 0; reg < 16; ++reg) { const int d = 64 * tb + 32 * dt + crow(reg, h); Cacc[dt][reg] = C0[(size_t)d * 256 + 64 * sl + 32 * eh + r]; }
            m_prev = P.in[I_SM][sbase];
        }
#pragma unroll
        for (int dt = 0; dt < 2; ++dt)
#pragma unroll
            for (int g = 0; g < 4; ++g) { u32x2 pk; pk.x = cvtpk(Cacc[dt][4 * g], Cacc[dt][4 * g + 1]); pk.y = cvtpk(Cacc[dt][4 * g + 2], Cacc[dt][4 * g + 3]);
                *(LAS u32x2*)(lds + ML_CT + (32 * eh + r) * MK_STR + (64 * tb + 32 * dt + 8 * g + 4 * h) * 2) = pk; }
        if (tid < 128) *(LAS unsigned*)(lds + ML_ZR + tid * 4) = 0u;
        if (tid < 256) { const float nv = ctx ? 0.f : P.in[I_SN][((size_t)(sidx * 2 + dir) * 4 + hd) * 256 + tid]; NF[tid] = nv; NB[tid] = (bf16_t)(cvtpk(nv, 0.f) & 0xffffu); }
    }
    const int gi = dir ? 2 : 0;
    const bf16x8 zero8 = {0, 0, 0, 0, 0, 0, 0, 0};
    bf16x8 qf[16];
    float decay = 1.f, m_new = 0.f;
#pragma unroll 1
    for (int c = -1; c < nc; ++c) {
        int l_tid = F.tid; asm volatile("" : "+v"(l_tid));
        const int tid = l_tid, lane = tid & 63, r = lane & 31, h = lane >> 5, g16 = (lane >> 4) & 1, q4 = (lane & 15) >> 2, p4 = lane & 3;
        const int ci = dir ? nc - 1 - c : c, base = R0 + ci * 128;
        const bool more = (c + 1 < nc);
        const int nbase = R0 + (dir ? nc - 2 - c : c + 1) * 128;
#define ROWOF(b_, i) ((b_) + (dir ? 127 - (i) : (i)))
        f32x16 nd;
        if (c >= 0) {
            const int trow = 32 * tb + r;
            const bf16_t* qrow_hi = Q1 + (size_t)ROWOF(base, trow) * D + hd * 256 + 8 * h + 128;
            const int hstride = dir ? -D : D;
            bf16_t* hp = HO + (size_t)(base + (dir ? 127 - 32 * tb : 32 * tb)) * D + hd * 256 + sl * 64 + 32 * eh;
            switch (tb) {
                case 0: mlstm_main<0>(lds, qf, qrow_hi, eh, wid, lane, hp, hstride); break;
                case 1: mlstm_main<1>(lds, qf, qrow_hi, eh, wid, lane, hp, hstride); break;
                case 2: mlstm_main<2>(lds, qf, qrow_hi, eh, wid, lane, hp, hstride); break;
                default: mlstm_main<3>(lds, qf, qrow_hi, eh, wid, lane, hp, hstride); break;
            }
        }
        float li0 = 0.f, lf0 = 0.f, li1 = 0.f, lf1 = 0.f;
        __builtin_amdgcn_sched_barrier(0);
        if (more) {
            const bf16_t* qrow = Q1 + (size_t)ROWOF(nbase, 32 * tb + r) * D + hd * 256 + 8 * h;
#pragma unroll
            for (int ks = 0; ks < 8; ++ks) qf[ks] = *(const bf16x8*)(qrow + 16 * ks);
            const float* g0 = GATES + (size_t)ROWOF(nbase, lane) * 16 + gi * 4 + hd; const float* g1 = GATES + (size_t)ROWOF(nbase, lane + 64) * 16 + gi * 4 + hd;
            li0 = g0[0]; lf0 = g0[4]; li1 = g1[0]; lf1 = g1[4];
        }
        if (c >= 0) {
#pragma unroll
            for (int dt = 0; dt < 2; ++dt) Cacc[dt] = Cacc[dt] * decay;
            nd = f32x16{};
#pragma unroll 2
            for (int ks = 0; ks < 8; ++ks) {
                LAS const unsigned char* wp = lds + ML_VW + (16 * ks + 8 * h + q4) * MV_STR + (32 * eh + 16 * g16 + 4 * p4) * 2;
                const bf16x8 bw = cat8(ldtr(wp), ldtr(wp + 4 * MV_STR));
                const bf16x8 wsv = *(const LAS bf16x8*)(lds + ML_WSB + ks * 32 + h * 16);
#pragma unroll
                for (int dt = 0; dt < 2; ++dt) {
                    LAS const unsigned char* kp = lds + ML_KT + (16 * ks + 8 * h + q4) * MK_STR + (64 * tb + 32 * dt + 16 * g16 + 4 * p4) * 2;
                    const bf16x8 ak = cat8(ldtr(kp), ldtr(kp + 4 * MK_STR));
                    Cacc[dt] = MFMA32(ak, bw, Cacc[dt]);
                    if (eh == 0) nd = MFMA32((r == dt) ? wsv : zero8, ak, nd);
                }
                __builtin_amdgcn_sched_barrier(0);
            }
        }
        __syncthreads();
        if (c >= 0) {
#pragma unroll
            for (int dt = 0; dt < 2; ++dt)
#pragma unroll
                for (int g = 0; g < 4; ++g) { u32x2 pk; pk.x = cvtpk(Cacc[dt][4 * g], Cacc[dt][4 * g + 1]); pk.y = cvtpk(Cacc[dt][4 * g + 2], Cacc[dt][4 * g + 3]);
                    *(LAS u32x2*)(lds + ML_CT + (32 * eh + r) * MK_STR + (64 * tb + 32 * dt + 8 * g + 4 * h) * 2) = pk; }
            if (eh == 0 && h == 0) {
#pragma unroll
                for (int dt = 0; dt < 2; ++dt) { const int d = 64 * tb + 32 * dt + r; const float nv = decay * NF[d] + nd[dt]; NF[d] = nv; NB[d] = (bf16_t)(cvtpk(nv, 0.f) & 0xffffu); }
            }
            m_prev = m_new;
        }
        if (more) {
            u32x4 kreg[8], vreg[2];
#pragma unroll
            for (int j = 0; j < 8; ++j) { const int idx = tid + 512 * j, i = idx >> 5, ch = idx & 31; kreg[j] = *(const u32x4*)(K1 + (size_t)ROWOF(nbase, i) * D + hd * 256 + ch * 8); }
#pragma unroll
            for (int j = 0; j < 2; ++j) { const int i = (tid >> 3) + 64 * j, ch = tid & 7; vreg[j] = *(const u32x4*)(V1 + (size_t)ROWOF(nbase, i) * D + hd * 256 + sl * 64 + ch * 8); }
            __builtin_amdgcn_sched_barrier(0);
            const int i0 = lane, i1 = lane + 64;
            const float b0 = scan_sum(lf0, lane); const float tot = __int_as_float(__builtin_amdgcn_readlane(__float_as_int(b0), 63)); const float b1 = scan_sum(lf1, lane) + tot;
            const float u0 = li0 - b0, u1 = li1 - b1;
            const float cm0 = scan_max(u0, lane); const float top = __int_as_float(__builtin_amdgcn_readlane(__float_as_int(cm0), 63)); const float cm1 = fmaxf(scan_max(u1, lane), top);
            const float M0 = fmaxf(m_prev, cm0), M1 = fmaxf(m_prev, cm1);
            const float b_end = __int_as_float(__builtin_amdgcn_readlane(__float_as_int(b1), 63)), Mend = __int_as_float(__builtin_amdgcn_readlane(__float_as_int(M1), 63));
            const float ws0 = __expf(u0 - Mend), ws1 = __expf(u1 - Mend);
            decay = __expf(m_prev - Mend); m_new = b_end + Mend;
            if (wid == 0) { UV[i0] = u0 * 1.4426950408889634f; UV[i1] = u1 * 1.4426950408889634f; MV[i0] = M0 * 1.4426950408889634f; MV[i1] = M1 * 1.4426950408889634f; WI[i0] = __expf(m_prev - M0); WI[i1] = __expf(m_prev - M1);
                CL[i0] = __expf(-(b0 + M0)); CL[i1] = __expf(-(b1 + M1)); WSB[i0] = (bf16_t)(cvtpk(ws0, 0.f) & 0xffffu); WSB[i1] = (bf16_t)(cvtpk(ws1, 0.f) & 0xffffu); }
#pragma unroll
            for (int j = 0; j < 8; ++j) { const int idx = tid + 512 * j, i = idx >> 5, ch = idx & 31; *(LAS u32x4*)(lds + ML_KT + i * MK_STR + ch * 16) = kreg[j]; }
#pragma unroll
            for (int j = 0; j < 2; ++j) { const int i = (tid >> 3) + 64 * j, ch = tid & 7;
                const float wv = __shfl(j ? ws1 : ws0, (tid >> 3) & 63);
                float f[8]; unpack8(vreg[j], f);
                u32x4 w; w.x = cvtpk(f[0] * wv, f[1] * wv); w.y = cvtpk(f[2] * wv, f[3] * wv); w.z = cvtpk(f[4] * wv, f[5] * wv); w.w = cvtpk(f[6] * wv, f[7] * wv);
                *(LAS u32x4*)(lds + ML_VT + i * MV_STR + ch * 16) = vreg[j]; *(LAS u32x4*)(lds + ML_VW + i * MV_STR + ch * 16) = w; }
        }
        __syncthreads();
#undef ROWOF
    }
    if (ctx) {
        int l_tid = F.tid; asm volatile("" : "+v"(l_tid));
        const int tid = l_tid, lane = tid & 63, r = lane & 31, h = lane >> 5;
        const size_t sbase = ((size_t)(sidx * 2 + dir) * 4 + hd);
        float* Co = P.out + OUT_SC + sbase * 65536;
#pragma unroll
        for (int dt = 0; dt < 2; ++dt)
#pragma unroll
            for (int reg = 0; reg < 16; ++reg) { const int d = 64 * tb + 32 * dt + crow(reg, h);
                Co[(size_t)d * 256 + 64 * sl + 32 * eh + r] = Cacc[dt][reg];
                if (sl == 0 && eh == 0 && r == 0) P.out[OUT_SN + sbase * 256 + d] = NF[d]; }
        if (sl == 0 && tid == 0) P.out[OUT_SM + sbase] = m_prev;
    }
    __syncthreads();
}
DI void phase_mlstm(const Frame& F, const Params& P) {
#pragma unroll 1
    for (int it = F.vcu; it < 768; it += F.G) {
        const bool ctx = it >= 256; const int j = ctx ? it - 256 : it;
        const int sl = j & 3, dir = (j >> 2) & 1, hd = (j >> 3) & 3, sq = j >> 5;
        mlstm_item(F, P, ctx ? sq * SEQ_C : T_CTX + sq * SEQ_S, ctx ? SEQ_C : SEQ_S, sq, ctx, hd, dir, sl);
    }
}

constexpr int UP_EARLY = 2;
constexpr int NPHASE = 18;
__global__ void __launch_bounds__(512, 2) hybrid_fwd(Params P) {
    extern __shared__ __attribute__((aligned(16))) unsigned char lds_raw[];
    Frame F;
    F.lds = (LAS unsigned char*)lds_raw;
    F.wave = __builtin_amdgcn_readfirstlane((int)threadIdx.x >> 6); F.lane = hw_lane(); F.tid = F.wave * 64 + F.lane;
    F.G = gridDim.x; { const int bx = blockIdx.x; F.vcu = (F.G % 8 == 0) ? (bx % 8) * (F.G / 8) + bx / 8 : bx; }
    F.gw = F.vcu * 8 + F.wave; F.NGW = F.G * 8;
    unsigned char* ws = P.ws;
    volatile LAS unsigned* MISC = (volatile LAS unsigned*)(F.lds + MISC_OFF);
    if (F.tid < 64) MISC[F.tid] = 0u;
    __syncthreads();
#if MK_PER_PHASE
#define GRID_BAR() do { } while (0)
#else
    if (P.never) cg::this_grid().sync();
    XcdBarrier bar = xcd_barrier_post((unsigned*)(ws + WS_BAR), MISC + 8, F.wave);
#define GRID_BAR() xcd_barrier(bar)
#endif
    const int lo = P.ph_lo, hi = P.ph_hi;
#ifndef PH_MASK
#define PH_MASK 0x3ffff
#endif
#define IN(k) (((PH_MASK >> (k)) & 1) && lo <= (k) && (k) < hi)
#define SEAM(k) do { if (IN(k) && IN((k) + 1)) GRID_BAR(); { F.lane = hw_lane(); F.tid = F.wave * 64 + F.lane; } } while (0)
    bf16_t* XR = (bf16_t*)((unsigned char*)P.out + 72 * MiB);
    bf16_t* X4 = (bf16_t*)(ws + WS_S5);
    const float* MOD0 = (const float*)(ws + WS_MOD); const float* MOD1 = MOD0 + 9 * 6144;
    bf16_t* H = (bf16_t*)(ws + WS_H);

    const float* BIAS = (const float*)(ws + WS_BIAS);
    float* RSQA = (float*)(ws + WS_RSQA); float* RSQB = (float*)(ws + WS_RSQB); float* RSQC = (float*)(ws + WS_RSQC);
    const bf16_t* UB = (const bf16_t*)(ws + WS_UBUF);

    const bool ovl = (F.G == 256) && !MK_PER_PHASE;
    if (IN(0)) { p0_prologue(F, P);
#if defined(PROBE_DUP) && (PROBE_DUP & 1)
        GRID_BAR(); p0_prologue(F, P);
#endif
    }
    SEAM(0);
    if (IN(1)) { modulate_rows(F, P.in[I_XP], P.in[I_XS], P.in[I_N1W], MOD0, 0, 1024, H);
#if defined(PROBE_DUP) && (PROBE_DUP & 2)
        GRID_BAR(); modulate_rows(F, P.in[I_XP], P.in[I_XS], P.in[I_N1W], MOD0, 0, 1024, H);
#endif
    }
    SEAM(1);
    if (IN(2)) {
        pg8::PlainOrder S; S.init(H, (const bf16_t*)(ws + WS_WIN0), D, D, T_ALL, NIN0, F.G, (int)blockIdx.x);
        EpiIn0 E{(bf16_t*)(ws + WS_Q), (bf16_t*)(ws + WS_KS), (bf16_t*)(ws + WS_VS), (bf16_t*)(ws + WS_KC), (bf16_t*)(ws + WS_VC), (bf16_t*)(ws + WS_GU), (bf16_t*)(ws + WS_GV),
                 P.out + OUT_CK, P.out + OUT_CV, (float*)(ws + WS_ROWSQ), (const float*)(ws + WS_ROPE)};
        pg8::gemm_phase(F.lds, S, E, D, D, F.tid);
        if (F.G == 256) { if ((int)blockIdx.x >= 160) { F.lane = hw_lane(); F.tid = F.wave * 64 + F.lane; bias_gemv(F, P, (int)blockIdx.x - 160, 96); } }
        else { F.lane = hw_lane(); F.tid = F.wave * 64 + F.lane; bias_gemv(F, P, (int)blockIdx.x, F.G); }
#if defined(PROBE_GEMM) && ((PROBE_GEMM >> 2) & 1)
        { GRID_BAR(); EpiNull EN{(float*)(ws + WS_LAM) + 8}; pg8::gemm_phase(F.lds, S, EN, D, D, F.tid); }
#endif
    }
    SEAM(2);
    if (IN(3)) { phase_mix0(F, P);
#if defined(PROBE_DUP) && (PROBE_DUP & 8)
        GRID_BAR(); phase_mix0(F, P);
#endif
    }
    SEAM(3);
    if (IN(4)) {
        const EpiRes<true, true> E{P.in[I_XP], P.in[I_XS], nullptr, XR, MOD0, 2048, H, P.in[I_N2W], MOD0, 4096, RSQA};
        { pg8::PanelOrder S; S.init((const bf16_t*)(ws + WS_MIX), (const bf16_t*)(ws + WS_WOUT0), D, D, T_ALL, F.G, (int)blockIdx.x, 0, ovl ? 2 : (1 << 20));
          pg8::gemm_phase(F.lds, S, E, D, D, F.tid); }
        if (ovl) {
            GRID_BAR(); F.lane = hw_lane(); F.tid = F.wave * 64 + F.lane;
            if ((int)blockIdx.x < 64) { F.lane = hw_lane(); F.tid = F.wave * 64 + F.lane; pg8::PanelOrder S; S.init((const bf16_t*)(ws + WS_MIX), (const bf16_t*)(ws + WS_WOUT0), D, D, T_ALL, F.G, (int)blockIdx.x, 2, 1 << 20);
                pg8::gemm_phase(F.lds, S, E, D, D, F.tid); }
            else { F.lane = hw_lane(); F.tid = F.wave * 64 + F.lane; pg8::SplitOrder S; S.init(H, (const bf16_t*)(ws + WS_WUP), D, D, 2 * DFF / 256, (int)blockIdx.x, true, UP_EARLY);
                EpiUpConv E1{(bf16_t*)(ws + WS_UBUF), (float*)(ws + WS_EDGE), P.in[I_FCW], P.in[I_FCB], (LAS float*)(F.lds + EDS_OFF), RSQA, BIAS + BIAS_UP0};
                pg8::gemm_phase(F.lds, S, E1, D, D, F.tid); }
        }
    }
    SEAM(4);
    if (IN(5)) {
        EpiUpConv E{(bf16_t*)(ws + WS_UBUF), (float*)(ws + WS_EDGE), P.in[I_FCW], P.in[I_FCB], (LAS float*)(F.lds + EDS_OFF), RSQA, BIAS + BIAS_UP0};
        if (ovl) { pg8::SplitOrder S; S.init(H, (const bf16_t*)(ws + WS_WUP), D, D, 2 * DFF / 256, (int)blockIdx.x, false, UP_EARLY);
            pg8::gemm_phase(F.lds, S, E, D, D, F.tid); }
        else { pg8::PlainOrder S; S.init(H, (const bf16_t*)(ws + WS_WUP), D, D, T_ALL, 2 * DFF, F.G, (int)blockIdx.x);
            pg8::gemm_phase(F.lds, S, E, D, D, F.tid); }
    }
    SEAM(5);
    if (IN(7)) {
        ffn_fixup_own(F, (bf16_t*)(ws + WS_UBUF), (const float*)(ws + WS_EDGE), P.in[I_FCW], (int)blockIdx.x);
        const EpiRes<true, false> E{nullptr, nullptr, XR, XR, MOD0, 5120, H, P.in[I_N1W] + D, MOD1, 1024, RSQB};
        { pg8::PanelOrder S; S.init(UB, (const bf16_t*)(ws + WS_WDOWN), DFF, DFF, T_ALL, F.G, (int)blockIdx.x, 0, ovl ? 2 : (1 << 20));
          pg8::gemm_phase(F.lds, S, E, DFF, DFF, F.tid); }
        if (ovl) {
            GRID_BAR(); F.lane = hw_lane(); F.tid = F.wave * 64 + F.lane;
            if ((int)blockIdx.x < 64) { F.lane = hw_lane(); F.tid = F.wave * 64 + F.lane; pg8::PanelOrder S; S.init(UB, (const bf16_t*)(ws + WS_WDOWN), DFF, DFF, T_ALL, F.G, (int)blockIdx.x, 2, 1 << 20);
                pg8::gemm_phase(F.lds, S, E, DFF, DFF, F.tid); }
            else { F.lane = hw_lane(); F.tid = F.wave * 64 + F.lane; pg8::SplitOrder S; S.init(H, (const bf16_t*)(ws + WS_WIN1), D, D, NIN1P / 256, (int)blockIdx.x, true, 3);
                EpiIn1 E1{(bf16_t*)(ws + WS_XM), (bf16_t*)(ws + WS_OG), (float*)(ws + WS_GATES), P.in[I_BG], RSQB, BIAS + BIAS_IN1};
                pg8::gemm_phase(F.lds, S, E1, D, D, F.tid); }
        }
    }
    SEAM(7);
    if (IN(8)) {
        EpiIn1 E{(bf16_t*)(ws + WS_XM), (bf16_t*)(ws + WS_OG), (float*)(ws + WS_GATES), P.in[I_BG], RSQB, BIAS + BIAS_IN1};
        if (ovl) { pg8::SplitOrder S; S.init(H, (const bf16_t*)(ws + WS_WIN1), D, D, NIN1P / 256, (int)blockIdx.x, false, 3);
            pg8::gemm_phase(F.lds, S, E, D, D, F.tid); }
        else { pg8::PlainOrder S; S.init(H, (const bf16_t*)(ws + WS_WIN1), D, D, T_ALL, NIN1P, F.G, (int)blockIdx.x);
            pg8::gemm_phase(F.lds, S, E, D, D, F.tid); }
    }
    SEAM(8);
    if (IN(9)) { mconv_rows(F, (const bf16_t*)(ws + WS_XM), (bf16_t*)(ws + WS_XC), P.in[I_MCW], P.in[I_MCB]);
#if defined(PROBE_DUP) && (PROBE_DUP & 0x200)
        GRID_BAR(); mconv_rows(F, (const bf16_t*)(ws + WS_XM), (bf16_t*)(ws + WS_XC), P.in[I_MCW], P.in[I_MCB]);
#endif
    }
    SEAM(9);
    if (IN(10)) {
        QkvOrder S; S.init((const bf16_t*)(ws + WS_XC), (const bf16_t*)(ws + WS_XM), (const bf16_t*)(ws + WS_WQKV1), F.G, (int)blockIdx.x);
        EpiQkv1 E{(bf16_t*)(ws + WS_Q1), (bf16_t*)(ws + WS_K1), (bf16_t*)(ws + WS_V1)};
        int kq = 256; asm volatile("" : "+s"(kq));
        pg8::gemm_phase(F.lds, S, E, D, kq, F.tid);
#if defined(PROBE_GEMM) && ((PROBE_GEMM >> 10) & 1)
        { GRID_BAR(); EpiNull EN{(float*)(ws + WS_LAM) + 8}; pg8::gemm_phase(F.lds, S, EN, D, kq, F.tid); }
#endif
    }
    SEAM(10);
    if (IN(11)) { phase_mlstm(F, P);
#if defined(PROBE_DUP) && (PROBE_DUP & 0x800)
        GRID_BAR(); phase_mlstm(F, P);
#endif
    }
    SEAM(11);
    if (IN(12)) { p16_weights(F, P); mpost_rows(F, (const bf16_t*)(ws + WS_HF), (const bf16_t*)(ws + WS_HB), (const bf16_t*)(ws + WS_OG), (const bf16_t*)(ws + WS_XC), P.in[I_HNW], P.in[I_SKIP], (bf16_t*)(ws + WS_Y1));
#if defined(PROBE_DUP) && (PROBE_DUP & 0x1000)
        GRID_BAR(); p16_weights(F, P); mpost_rows(F, (const bf16_t*)(ws + WS_HF), (const bf16_t*)(ws + WS_HB), (const bf16_t*)(ws + WS_OG), (const bf16_t*)(ws + WS_XC), P.in[I_HNW], P.in[I_SKIP], (bf16_t*)(ws + WS_Y1));
#endif
    }
    SEAM(12);
    if (IN(13)) {
        const EpiRes<true, false> E{nullptr, nullptr, XR, XR, MOD1, 2048, H, P.in[I_N2W] + D, MOD1, 4096, RSQC};
        { pg8::PanelOrder S; S.init((const bf16_t*)(ws + WS_Y1), (const bf16_t*)(ws + WS_WOUT1), D, D, T_ALL, F.G, (int)blockIdx.x, 0, ovl ? 2 : (1 << 20));
          pg8::gemm_phase(F.lds, S, E, D, D, F.tid); }
        if (ovl) {
            GRID_BAR(); F.lane = hw_lane(); F.tid = F.wave * 64 + F.lane;
            if ((int)blockIdx.x < 64) { F.lane = hw_lane(); F.tid = F.wave * 64 + F.lane; pg8::PanelOrder S; S.init((const bf16_t*)(ws + WS_Y1), (const bf16_t*)(ws + WS_WOUT1), D, D, T_ALL, F.G, (int)blockIdx.x, 2, 1 << 20);
                pg8::gemm_phase(F.lds, S, E, D, D, F.tid); }
            else { F.lane = hw_lane(); F.tid = F.wave * 64 + F.lane; pg8::SplitOrder S; S.init(H, (const bf16_t*)(ws + WS_WUP1), D, D, 2 * DFF / 256, (int)blockIdx.x, true, UP_EARLY);
                EpiUpConv E1{(bf16_t*)(ws + WS_UBUF), (float*)(ws + WS_EDGE), P.in[I_FCW] + 3 * DFF, P.in[I_FCB] + DFF, (LAS float*)(F.lds + EDS_OFF), RSQC, BIAS + BIAS_UP1};
                pg8::gemm_phase(F.lds, S, E1, D, D, F.tid); }
        }
    }
    SEAM(13);
    if (IN(14)) {
        EpiUpConv E{(bf16_t*)(ws + WS_UBUF), (float*)(ws + WS_EDGE), P.in[I_FCW] + 3 * DFF, P.in[I_FCB] + DFF, (LAS float*)(F.lds + EDS_OFF), RSQC, BIAS + BIAS_UP1};
        if (ovl) { pg8::SplitOrder S; S.init(H, (const bf16_t*)(ws + WS_WUP1), D, D, 2 * DFF / 256, (int)blockIdx.x, false, UP_EARLY);
            pg8::gemm_phase(F.lds, S, E, D, D, F.tid); }
        else { pg8::PlainOrder S; S.init(H, (const bf16_t*)(ws + WS_WUP1), D, D, T_ALL, 2 * DFF, F.G, (int)blockIdx.x);
            pg8::gemm_phase(F.lds, S, E, D, D, F.tid); }
    }
    SEAM(14);
    if (IN(16)) {
        ffn_fixup_own(F, (bf16_t*)(ws + WS_UBUF), (const float*)(ws + WS_EDGE), P.in[I_FCW] + 3 * DFF, (int)blockIdx.x);
        const EpiRes<false, false> E{nullptr, nullptr, XR, X4, MOD1, 5120, nullptr, nullptr, nullptr, 0, nullptr};
        { pg8::PanelOrder S; S.init(UB, (const bf16_t*)(ws + WS_WDOWN1), DFF, DFF, T_ALL, F.G, (int)blockIdx.x, 0, 2);
          pg8::gemm_phase(F.lds, S, E, DFF, DFF, F.tid); }
        GRID_BAR(); F.lane = hw_lane(); F.tid = F.wave * 64 + F.lane;
        if ((int)blockIdx.x < 64 || !ovl) { F.lane = hw_lane(); F.tid = F.wave * 64 + F.lane; pg8::PanelOrder S; S.init(UB, (const bf16_t*)(ws + WS_WDOWN1), DFF, DFF, T_ALL, F.G, (int)blockIdx.x, 2, 1 << 20);
          pg8::gemm_phase(F.lds, S, E, DFF, DFF, F.tid); }
        else { F.lane = hw_lane(); F.tid = F.wave * 64 + F.lane; final_norm_rows(F, X4, P.out, P.in[I_FNW], 0, 128 * 256, ((int)blockIdx.x - 64) * 8 + F.wave, 192 * 8); }
    }
    SEAM(16);
    if (IN(17)) final_norm_rows(F, X4, P.out, P.in[I_FNW], ovl ? 128 * 256 : 0, T_ALL, F.gw, F.NGW);
#undef IN
#undef SEAM
}

extern "C" void kernel_launch(void* const* d_in, const int* in_sizes, int n_in, void* d_out, int out_size, void* d_ws, size_t ws_size, hipStream_t stream) {
    static int grid = 0;
    if (grid == 0) {
        if (n_in != 38 || ws_size < WS_END) { fprintf(stderr, "kernel_launch: expected 38 inputs and >= %zu bytes of workspace (got %d, %zu)\n", (size_t)WS_END, n_in, ws_size); grid = -1; return; }
        int dev = 0, cus = 0, per_cu = 0;
        if (hipGetDevice(&dev) != hipSuccess || hipDeviceGetAttribute(&cus, hipDeviceAttributeMultiprocessorCount, dev) != hipSuccess) { grid = -1; return; }
        if (hipFuncSetAttribute((const void*)hybrid_fwd, hipFuncAttributeMaxDynamicSharedMemorySize, LDS_BYTES) != hipSuccess) { fprintf(stderr, "kernel_launch: hipFuncSetAttribute failed\n"); grid = -1; return; }
        if (hipOccupancyMaxActiveBlocksPerMultiprocessor(&per_cu, (const void*)hybrid_fwd, 512, LDS_BYTES) != hipSuccess || per_cu < 1) { fprintf(stderr, "kernel_launch: occupancy query says %d blocks per CU\n", per_cu); per_cu = 1; }
        (void)hipGetLastError();
        grid = cus;
    }
    if (grid < 0) return;
    (void)hipMemsetAsync((char*)d_ws, 0, WS_ZERO_BYTES, stream);
    Params p{};
    for (int i = 0; i < 38; ++i) p.in[i] = (const float*)d_in[i];
    p.out = (float*)d_out; p.ws = (unsigned char*)d_ws; p.never = 0; p.pad = 0;
#if MK_PER_PHASE
    for (int ph = 0; ph < NPHASE; ++ph) { p.ph_lo = ph; p.ph_hi = ph + 1; hipLaunchKernelGGL(hybrid_fwd, dim3(grid), dim3(512), LDS_BYTES, stream, p); }
#else
    p.ph_lo = 0; p.ph_hi = NPHASE;
    void* args[] = {&p};
    hipError_t e = hipLaunchCooperativeKernel((const void*)hybrid_fwd, dim3(grid), dim3(512), args, LDS_BYTES, stream);
    if (e != hipSuccess) fprintf(stderr, "kernel_launch: cooperative launch failed: %s (grid %d)\n", hipGetErrorString(e), grid);
#endif
}
```

```cpp
#include <hip/hip_runtime.h>
#include <hip/hip_cooperative_groups.h>
#include <cstdio>
#include <cstdint>
namespace cg = cooperative_groups;

#ifndef MK_PER_PHASE
#define MK_PER_PHASE 0
#endif

#define DI __device__ __forceinline__
#define LAS __attribute__((address_space(3)))
typedef unsigned short bf16_t;
typedef short bf16x8 __attribute__((ext_vector_type(8)));
typedef short s16x4 __attribute__((ext_vector_type(4)));
typedef float f32x2 __attribute__((ext_vector_type(2)));
typedef float f32x4 __attribute__((ext_vector_type(4)));
typedef float f32x16 __attribute__((ext_vector_type(16)));
typedef unsigned u32x2 __attribute__((ext_vector_type(2)));
typedef unsigned u32x4 __attribute__((ext_vector_type(4)));
typedef __bf16 bf16x2_t __attribute__((ext_vector_type(2)));

constexpr int D = 1024, T_CTX = 4096, T_SMP = 32768, T_ALL = 36864, SEQ_C = 256, SEQ_S = 4096, PAST = 512, LKS = 4608;
constexpr int DFF = 2816, NIN0 = 2560, NIN1P = 2304, NIN1 = 2064;
constexpr float EPS = 1e-6f;
constexpr float ATT_C2 = 0.125f * 1.4426950408889634f;
constexpr float LAM_INIT = 0.2f;

constexpr size_t MiB = 1u << 20;
constexpr size_t WS_BAR = 0;
constexpr size_t WS_ROWSQ = 64 * 1024;
constexpr size_t WS_RSQA = WS_ROWSQ + 147456, WS_RSQB = WS_RSQA + 147456, WS_RSQC = WS_RSQB + 147456;
constexpr size_t WS_ZERO_BYTES = 1024 * 1024;
constexpr size_t WS_MOD = 509 * MiB + 512 * 1024;
constexpr size_t WS_ROPE = 510 * MiB;
constexpr size_t WS_LAM = 510 * MiB + 16 * 1024;
constexpr size_t WS_BIAS = 510 * MiB + 256 * 1024;
constexpr int BIAS_UP0 = 0, BIAS_IN1 = 9 * 5632, BIAS_UP1 = BIAS_IN1 + 9 * 2304;
constexpr size_t SLOT = 72 * MiB;
constexpr size_t WS_S0 = 1 * MiB, WS_S1 = WS_S0 + SLOT, WS_S2 = WS_S1 + SLOT, WS_S3 = WS_S2 + SLOT, WS_S4 = WS_S3 + SLOT, WS_S5 = WS_S4 + SLOT, WS_S6 = WS_S5 + SLOT;
constexpr size_t WS_GATES = 505 * MiB;
constexpr size_t WS_WOUT1 = 507 * MiB + 512 * 1024;
constexpr size_t WS_END = 512 * MiB;
constexpr size_t WS_H = WS_S0;
constexpr size_t WS_Q = WS_S1, WS_KS = WS_S1 + 36 * MiB;
constexpr size_t WS_VS = WS_S2, WS_GU = WS_S2 + 36 * MiB;
constexpr size_t WS_GV = WS_S3, WS_KC = WS_S3 + 36 * MiB, WS_VC = WS_S3 + 40 * MiB;
constexpr size_t WS_MIX = WS_S4;
constexpr size_t WS_ASCR = WS_S5;
constexpr size_t WS_UBUF = 73 * MiB, WS_EDGE = 271 * MiB;
constexpr size_t WS_WUP = 469 * MiB, WS_WDOWN = 480 * MiB;
constexpr size_t WS_WIN0 = 486 * MiB, WS_WOUT0 = 491 * MiB;
constexpr size_t WS_XC = WS_S0, WS_XM = WS_S1, WS_HF = WS_S1, WS_OG = WS_S2, WS_Q1 = WS_S3, WS_Y1 = WS_S3, WS_K1 = WS_S4, WS_V1 = WS_S5, WS_HB = WS_S6;
constexpr size_t WS_WIN1 = 493 * MiB, WS_WQKV1 = 498 * MiB;
constexpr size_t WS_WUP1 = WS_S4, WS_WDOWN1 = WS_S4 + 11 * MiB;
static_assert(WS_S6 + SLOT == 505 * MiB && WS_WOUT1 + 2 * MiB <= WS_MOD && WS_GATES + (size_t)T_ALL * 64 <= WS_WOUT1 && WS_RSQC + 147456 <= WS_ZERO_BYTES && WS_BIAS + (size_t)(BIAS_UP1 + 9 * 5632) * 4 <= WS_END && WS_MOD + 442368 <= WS_ROPE, "ws map");
static_assert(WS_UBUF + (size_t)T_ALL * DFF * 2 == WS_EDGE && WS_EDGE + (size_t)144 * 6 * DFF * 4 <= WS_WUP && WS_WOUT0 + 2 * MiB <= WS_S6 + SLOT && WS_WIN0 >= WS_S6, "ws map 2");
static_assert(WS_WQKV1 + 3 * MiB / 2 <= WS_S6 + SLOT && WS_WIN1 >= WS_WOUT0 + 2 * MiB && WS_WDOWN1 + 6 * MiB <= WS_S5 && WS_WUP1 >= WS_EDGE + 10 * MiB, "ws map 3");

constexpr size_t OUT_Y = 0, OUT_CK = (size_t)T_ALL * D, OUT_CV = OUT_CK + 2097152, OUT_SC = OUT_CV + 2097152, OUT_SN = OUT_SC + 8388608, OUT_SM = OUT_SN + 32768;

constexpr int LDS_BYTES = 163840;
constexpr int MISC_OFF = 163840 - 256;

struct Params { const float* in[38]; float* out; unsigned char* ws; int ph_lo, ph_hi, never, pad; };
enum { I_XP = 0, I_XS, I_CK, I_CV, I_SC, I_SN, I_SM, I_C, I_CCTX, I_WMOD, I_BMOD, I_N1W, I_N2W, I_WIN0, I_LQ1, I_LK1, I_LQ2, I_LK2, I_SUBLN, I_GNW, I_WSP, I_BSP, I_WOUT0,
       I_WIN1, I_BG, I_MCW, I_MCB, I_WQ, I_WK, I_WV, I_HNW, I_SKIP, I_WOUT1, I_WUP, I_FCW, I_FCB, I_WDOWN, I_FNW };

DI unsigned cvtpk(float lo, float hi) { f32x2 v = {lo, hi}; bf16x2_t b = __builtin_convertvector(v, bf16x2_t); return __builtin_bit_cast(unsigned, b); }
DI float bf2f(unsigned short b) { return __uint_as_float(((unsigned)b) << 16); }
DI float bflo(unsigned w) { return __uint_as_float(w << 16); }
DI float bfhi(unsigned w) { return __uint_as_float(w & 0xffff0000u); }
DI float silu_f(float x) { return x * __builtin_amdgcn_rcpf(1.f + __builtin_amdgcn_exp2f(-1.4426950408889634f * x)); }
DI float sigmoid_f(float x) { return __builtin_amdgcn_rcpf(1.f + __builtin_amdgcn_exp2f(-1.4426950408889634f * x)); }
DI float gelu_f(float x) { const float t = x * x; const float u = x * (-2.302208198482644f - 0.10294324276f * t); return x * __builtin_amdgcn_rcpf(1.f + __builtin_amdgcn_exp2f(u)); }
typedef float f32x2 __attribute__((ext_vector_type(2)));
DI f32x2 gelu_gate2(f32x2 x, f32x2 g) {
    const f32x2 t = x * x, u = x * (t * -0.10294324276f + -2.302208198482644f);
    f32x2 e; e.x = __builtin_amdgcn_exp2f(u.x); e.y = __builtin_amdgcn_exp2f(u.y);
    const f32x2 d = e + 1.f; f32x2 r; r.x = __builtin_amdgcn_rcpf(d.x); r.y = __builtin_amdgcn_rcpf(d.y);
    return (x * g) * r;
}
DI float logsigmoid_f(float x) { return fminf(x, 0.f) - __logf(1.f + __expf(-fabsf(x))); }
DI float wave_sum(float v) {
#pragma unroll
    for (int o = 1; o < 64; o <<= 1) v += __shfl_xor(v, o);
    return v;
}
DI float max3f(float a, float b, float c) { float r; asm("v_max3_f32 %0, %1, %2, %3" : "=v"(r) : "v"(a), "v"(b), "v"(c)); return r; }
DI float max2f(float a, float b) { float r; asm("v_max_f32_e32 %0, %1, %2" : "=v"(r) : "v"(a), "v"(b)); return r; }
DI float xhalf_max(float v) { auto rr = __builtin_amdgcn_permlane32_swap(__float_as_uint(v), __float_as_uint(v), false, false); return max2f(__uint_as_float(rr[0]), __uint_as_float(rr[1])); }
DI float xhalf_sum(float v) { auto rr = __builtin_amdgcn_permlane32_swap(__float_as_uint(v), __float_as_uint(v), false, false); return __uint_as_float(rr[0]) + __uint_as_float(rr[1]); }
DI int crow(int reg, int h) { return (reg & 3) + 8 * (reg >> 2) + 4 * h; }
#define MFMA32(a, b, c) __builtin_amdgcn_mfma_f32_32x32x16_bf16((a), (b), (c), 0, 0, 0)
typedef short v4i16_t __attribute__((ext_vector_type(4)));
DI s16x4 ldtr(LAS const unsigned char* p) { return __builtin_bit_cast(s16x4, __builtin_amdgcn_ds_read_tr16_b64_v4i16((LAS v4i16_t*)p)); }
DI bf16x8 cat8(s16x4 lo, s16x4 hi) { return __builtin_shufflevector(lo, hi, 0, 1, 2, 3, 4, 5, 6, 7); }
DI bf16x8 pack8(const f32x16& x, int s) {
    u32x4 p; p[0] = cvtpk(x[8 * s], x[8 * s + 1]); p[1] = cvtpk(x[8 * s + 2], x[8 * s + 3]); p[2] = cvtpk(x[8 * s + 4], x[8 * s + 5]); p[3] = cvtpk(x[8 * s + 6], x[8 * s + 7]);
    return __builtin_bit_cast(bf16x8, p);
}
#define LDS_WAIT() asm volatile("s_waitcnt lgkmcnt(0)" ::: "memory")

#define XB_TMO      128
#define XB_XCNT(j)  (256  + 64 * (j))
#define XB_XSUB(j)  (1280 + 64 * (j))
#define XB_XGEN(j)  (2304 + 64 * (j))
#define XB_TOP      3328
#define XB_TOPGEN   3392
#define XCD_BAR_WORDS 3456
#define XB_SPIN_CAP (1u << 22)
DI unsigned xb_ld(unsigned* p)              { return __hip_atomic_load(p, __ATOMIC_RELAXED, __HIP_MEMORY_SCOPE_AGENT); }
DI unsigned xb_add(unsigned* p, unsigned v) { return __hip_atomic_fetch_add(p, v, __ATOMIC_RELAXED, __HIP_MEMORY_SCOPE_AGENT); }
DI int hw_lane() { int l_; asm volatile("v_mbcnt_lo_u32_b32 %0, -1, 0\n\tv_mbcnt_hi_u32_b32 %0, -1, %0" : "=v"(l_)); return l_; }
DI unsigned xb_xcc_id() { return (unsigned)__builtin_amdgcn_s_getreg((3 << 11) | 20) & 0xFu; }
#define XB_SPIN(cond, bar) do { unsigned _sp = 0; while (cond) { __builtin_amdgcn_s_sleep(1); \
    if ((++_sp & 255u) == 0u) { if (xb_ld(&(bar)[XB_TMO])) break; if (_sp > XB_SPIN_CAP) { atomicAdd(&(bar)[XB_TMO], 1u); break; } } } } while (0)
struct XcdBarrier { unsigned* bar; unsigned x; volatile LAS unsigned* st; int wave; };
DI XcdBarrier xcd_barrier_post(unsigned* bar, volatile LAS unsigned* st, int wave) {
    XcdBarrier b; b.bar = bar; b.x = xb_xcc_id(); b.st = st; b.wave = wave;
    if (wave == 0 && hw_lane() == 0) (void)xb_add(&bar[XB_XCNT(b.x)], 1u);
    return b;
}
DI void xcd_barrier_complete(unsigned* bar, unsigned x, unsigned& nloc, unsigned& nx) {
    const unsigned G = gridDim.x * gridDim.y * gridDim.z;
    unsigned sum, cnt, mine, sp = 0u;
    for (;;) {
        sum = 0u; cnt = 0u; mine = 0u;
#pragma unroll
        for (unsigned j = 0; j < 16; ++j) { const unsigned c = xb_ld(&bar[XB_XCNT(j)]); sum += c; cnt += (c > 0u) ? 1u : 0u; mine = (j == x) ? c : mine; }
        if (sum == G) break;
        __builtin_amdgcn_s_sleep(1);
        if ((++sp & 255u) == 0u) { if (xb_ld(&bar[XB_TMO])) break; if (sp > XB_SPIN_CAP) { atomicAdd(&bar[XB_TMO], 1u); break; } }
    }
    nloc = mine > 0u ? mine : 1u; nx = cnt > 0u ? cnt : 1u;
}
DI void xcd_barrier(const XcdBarrier& b) {
    asm volatile("s_waitcnt vmcnt(0)" ::: "memory");
    __syncthreads();
    if (b.wave == 0 && hw_lane() == 0) {
        unsigned* bar = b.bar;
        __builtin_amdgcn_s_waitcnt(0);
        unsigned nloc = b.st[0], nx = b.st[1];
        if (nloc == 0u) { xcd_barrier_complete(bar, b.x, nloc, nx); b.st[0] = nloc; b.st[1] = nx; }
        const unsigned old = xb_add(&bar[XB_XSUB(b.x)], 1u);
        const unsigned gen = old / nloc;
        if (old + 1u == (gen + 1u) * nloc) {
            __builtin_amdgcn_fence(__ATOMIC_RELEASE, "agent");
            asm volatile("s_waitcnt vmcnt(0)" ::: "memory");
            const unsigned og = xb_add(&bar[XB_TOP], 1u);
            const unsigned tg = og / nx;
            if (og + 1u == (tg + 1u) * nx) xb_add(&bar[XB_TOPGEN], 1u);
            else XB_SPIN(xb_ld(&bar[XB_TOPGEN]) == tg, bar);
            __builtin_amdgcn_fence(__ATOMIC_ACQUIRE, "agent");
            xb_add(&bar[XB_XGEN(b.x)], 1u);
            asm volatile("s_waitcnt vmcnt(0)" ::: "memory");
        } else {
            XB_SPIN(xb_ld(&bar[XB_XGEN(b.x)]) == gen, bar);
            __builtin_amdgcn_fence(__ATOMIC_ACQUIRE, "agent");
            asm volatile("s_waitcnt vmcnt(0)" ::: "memory");
        }
    }
    __syncthreads();
}

namespace pg8 {
constexpr int BM = 256, BK = 64, HALF = 128, HTB = HALF * BK * 2, STAGE_BYTES = 8 * HTB, NXCD = 8, WGM = 8;
DI int lds_byte(int r, int c) { const int st = (r >> 4) * 2 + (c >> 5), rr = r & 15, cc = c & 31, ob = rr * 64 + cc * 2; return st * 1024 + (ob ^ (((ob >> 9) & 1) << 5)); }
DI void stage_rc(int b, int& R, int& C) { const int st = b / 1024, sb = b % 1024, swz = sb ^ (((sb >> 9) & 1) << 5); R = (st >> 1) * 16 + swz / 64; C = (st & 1) * 32 + (swz % 64) / 2; }
DI int perm32(int rho) { const int n = rho >> 4, i = rho & 15; return 8 * (i >> 2) + 4 * n + (i & 3); }
struct Unit { int pm, pn, aux; };
struct PlainOrder {
    const bf16_t* A; const bf16_t* Bt; int lda, K, nM, nN, nwg, G, c;
    DI void init(const bf16_t* A_, const bf16_t* Bt_, int lda_, int K_, int M, int N, int G_, int c_) { A = A_; Bt = Bt_; lda = lda_; K = K_; nM = M / BM; nN = N / BM; nwg = nM * nN; G = G_; c = c_; }
    DI bool next(int i, Unit& u) const {
        const long L = (long)i * G + c; if (L >= nwg) return false;
        int wgid = (int)L; { const int q = nwg / NXCD, r = nwg % NXCD, xcd = wgid % NXCD, off = wgid / NXCD; wgid = (xcd < r ? xcd * (q + 1) : r * (q + 1) + (xcd - r) * q) + off; }
        const int nig = WGM * nN, gid = wgid / nig, fm = gid * WGM, gsz = (nM - fm) < WGM ? (nM - fm) : WGM;
        u.pm = fm + ((wgid % nig) % gsz); u.pn = (wgid % nig) / gsz; u.aux = 0; return true;
    }
    DI const char* a_ptr(const Unit& u) const { return (const char*)A + (size_t)u.pm * BM * lda * 2; }
    DI const char* b_ptr(const Unit& u) const { return (const char*)Bt + (size_t)u.pn * BM * K * 2; }
};

struct PanelOrder {
    const bf16_t* A; const bf16_t* Bt; int lda, K, nwg, G, c, r_lo, r_hi;
    DI void init(const bf16_t* A_, const bf16_t* Bt_, int lda_, int K_, int M, int G_, int c_, int r_lo_, int r_hi_) { A = A_; Bt = Bt_; lda = lda_; K = K_; nwg = (M / BM) * 4; G = G_; c = c_; r_lo = r_lo_; r_hi = r_hi_; }
    DI bool next(int i, Unit& u) const {
        const int rnd = i + r_lo; if (rnd >= r_hi) return false;
        const long L = (long)rnd * G + c; if (L >= nwg) return false;
        const int x = (int)(L % 8), off = (int)(L / 8);
        u.pm = 8 * (off >> 2) + x; u.pn = off & 3; u.aux = 0; return true;
    }
    DI const char* a_ptr(const Unit& u) const { return (const char*)A + (size_t)u.pm * BM * lda * 2; }
    DI const char* b_ptr(const Unit& u) const { return (const char*)Bt + (size_t)u.pn * BM * K * 2; }
};

struct SplitOrder {
    const bf16_t* A; const bf16_t* Bt; int lda, K, nN, x, start, stride, lc, max_i, total;
    DI void init(const bf16_t* A_, const bf16_t* Bt_, int lda_, int K_, int nN_, int c, bool early, int e) {
        A = A_; Bt = Bt_; lda = lda_; K = K_; nN = nN_; x = c & 7; total = 18 * nN_;
        if (early) { start = 0; stride = 24; lc = (c - 64) >> 3; max_i = (c >= 64) ? e : 0; }
        else { start = 24 * e; stride = 32; lc = c >> 3; max_i = 1 << 20; }
    }
    DI bool next(int i, Unit& u) const {
        if (i >= max_i) return false;
        const int lu = start + i * stride + lc; if (lu >= total) return false;
        const int g8 = 8 * nN, g = (lu < 2 * g8) ? lu / g8 : 2, r = lu - g * g8, gsz = (g < 2) ? 8 : 2;
        u.pm = 8 * (8 * g + r % gsz) + x; u.pn = r / gsz; u.aux = 0; return true;
    }
    DI const char* a_ptr(const Unit& u) const { return (const char*)A + (size_t)u.pm * BM * lda * 2; }
    DI const char* b_ptr(const Unit& u) const { return (const char*)Bt + (size_t)u.pn * BM * K * 2; }
};

template <class Epi, class Sched>
DI void gemm_phase(LAS unsigned char* lds, const Sched& S, const Epi& E, const int lda, const int K, const int tid) {
    const int wid = __builtin_amdgcn_readfirstlane(tid >> 6), lane = tid & 63, wr = wid >> 2, wc = wid & 3, fr = lane & 15, fq = lane >> 4;
    const int nt = K / BK;
    unsigned voffA[2], voffB[2];
#pragma unroll
    for (int i = 0; i < 2; ++i) { int R, C; stage_rc(tid * 16 + i * 8192, R, C); const int Rb = Epi::PERM ? ((R >> 5) * 64 + perm32(R & 31)) : R;
        const int Ra = Epi::AROW4 ? ((R & ~63) + 4 * (R & 15) + ((R >> 4) & 3)) : R;
        voffA[i] = (unsigned)(Ra * lda + C) * 2u; voffB[i] = (unsigned)(Rb * K + C) * 2u; }
    const size_t kstep = (size_t)(BK * 2);
    const size_t hstepA = (size_t)HALF * lda * 2, hstepB = (size_t)(Epi::PERM ? 32 : HALF) * K * 2;
    const unsigned ldsw = (unsigned)wid * 1024u;
    const int aoff = lds_byte(wr * 64 + fr, fq * 8), boff = lds_byte(wc * 32 + fr, fq * 8);
#define PG8_SA(b, h) (((b) * 2 + (h)) * HTB)
#define PG8_SB(b, h) ((4 + (b) * 2 + (h)) * HTB)
#define PG8_STAGE(bufoff, gbase, voff) do { _Pragma("unroll") for (int _i = 0; _i < 2; ++_i) \
        __builtin_amdgcn_global_load_lds((const unsigned*)((const char*)(gbase) + (voff)[_i]), (LAS unsigned*)(lds + (bufoff) + ldsw + _i * 8192), 16, 0, 0); } while (0)
#define PG8_LDA(dst, b, h) do { _Pragma("unroll") for (int m = 0; m < 4; ++m) _Pragma("unroll") for (int k = 0; k < 2; ++k) dst[m][k] = *(const LAS bf16x8*)(lds + PG8_SA(b, h) + aoff + m * 2048 + k * 1024); } while (0)
#define PG8_LDB(dst, b, h) do { _Pragma("unroll") for (int n = 0; n < 2; ++n) _Pragma("unroll") for (int k = 0; k < 2; ++k) dst[n][k] = *(const LAS bf16x8*)(lds + PG8_SB(b, h) + boff + n * 2048 + k * 1024); } while (0)
#define PG8_MMA(ai, bj, At, Bt) do { __builtin_amdgcn_s_setprio(1); _Pragma("unroll") for (int m = 0; m < 4; ++m) _Pragma("unroll") for (int n = 0; n < 2; ++n) _Pragma("unroll") for (int k = 0; k < 2; ++k) \
        acc[ai][bj][m][n] = __builtin_amdgcn_mfma_f32_16x16x32_bf16(Bt[n][k], At[m][k], acc[ai][bj][m][n], 0, 0, 0); __builtin_amdgcn_s_setprio(0); } while (0)
#define PG8_WAIT_V(n) asm volatile("s_waitcnt vmcnt(" #n ")" ::: "memory")
#define PG8_WAIT_L(n) asm volatile("s_waitcnt lgkmcnt(" #n ")" ::: "memory")
#define PG8_BAR __builtin_amdgcn_s_barrier()
#define PG8_SCHED __builtin_amdgcn_sched_barrier(0)
    Unit cur, nxt; int ui = 0;
    if (!S.next(0, cur)) return;
    f32x4 acc[2][2][4][2];
#pragma unroll
    for (int a = 0; a < 2; ++a)
#pragma unroll
        for (int b = 0; b < 2; ++b)
#pragma unroll
            for (int m = 0; m < 4; ++m)
#pragma unroll
                for (int n = 0; n < 2; ++n) acc[a][b][m][n] = (f32x4){0.f, 0.f, 0.f, 0.f};
    bf16x8 At[4][2], B0[2][2], B1[2][2];
    const char* cA = S.a_ptr(cur); const char* cB = S.b_ptr(cur);
    PG8_STAGE(PG8_SB(0, 0), cB, voffB); PG8_STAGE(PG8_SB(0, 1), cB + hstepB, voffB); PG8_STAGE(PG8_SA(0, 0), cA, voffA); PG8_STAGE(PG8_SA(0, 1), cA + hstepA, voffA);
    if (wr == 1) PG8_BAR;
    PG8_WAIT_V(2); PG8_BAR;
    PG8_STAGE(PG8_SB(1, 0), cB + kstep, voffB); PG8_STAGE(PG8_SA(1, 0), cA + kstep, voffA); PG8_STAGE(PG8_SB(1, 1), cB + hstepB + kstep, voffB);
    PG8_WAIT_V(6); PG8_BAR;
    for (;;) {
        const bool has_next = S.next(ui + 1, nxt);
        const char* nA = has_next ? S.a_ptr(nxt) : cA; const char* nB = has_next ? S.b_ptr(nxt) : cB;
        for (int t = 0; t < nt; t += 2) {
            const bool last = (t == nt - 2);
            const char* a1 = cA + (size_t)(t + 1) * kstep;
            const char* a2 = last ? nA : cA + (size_t)(t + 2) * kstep; const char* b2 = last ? nB : cB + (size_t)(t + 2) * kstep;
            const char* a3 = a2 + kstep; const char* b3 = b2 + kstep;
            PG8_LDB(B0, 0, 0); PG8_LDB(B1, 0, 1); PG8_SCHED; PG8_LDA(At, 0, 0); PG8_STAGE(PG8_SA(1, 1), a1 + hstepA, voffA);
            PG8_WAIT_V(8); PG8_WAIT_L(0); PG8_BAR; PG8_MMA(0, 0, At, B0); PG8_MMA(0, 1, At, B1); PG8_BAR; PG8_SCHED;
            PG8_LDA(At, 0, 1); PG8_STAGE(PG8_SB(0, 0), b2, voffB); PG8_STAGE(PG8_SB(0, 1), b2 + hstepB, voffB); PG8_STAGE(PG8_SA(0, 0), a2, voffA);
            PG8_WAIT_V(8); PG8_WAIT_L(0); PG8_BAR; PG8_MMA(1, 0, At, B0); PG8_MMA(1, 1, At, B1); PG8_BAR; PG8_SCHED;
            PG8_LDB(B0, 1, 0); PG8_LDB(B1, 1, 1); PG8_SCHED; PG8_LDA(At, 1, 0); PG8_STAGE(PG8_SA(0, 1), a2 + hstepA, voffA);
            PG8_WAIT_V(8); PG8_WAIT_L(0); PG8_BAR; PG8_MMA(0, 0, At, B0); PG8_MMA(0, 1, At, B1); PG8_BAR; PG8_SCHED;
            PG8_LDA(At, 1, 1); PG8_STAGE(PG8_SB(1, 0), b3, voffB); PG8_STAGE(PG8_SB(1, 1), b3 + hstepB, voffB); PG8_STAGE(PG8_SA(1, 0), a3, voffA);
            PG8_WAIT_V(8); PG8_WAIT_L(0); PG8_BAR; PG8_MMA(1, 0, At, B0); PG8_MMA(1, 1, At, B1); PG8_BAR; PG8_SCHED;
        }
        if (wr == 0) PG8_BAR;
        { const int l_ = hw_lane(); E(acc, cur, wr, wc, l_ & 15, l_ >> 4); }
        if (!has_next) break;
#pragma unroll
        for (int a = 0; a < 2; ++a)
#pragma unroll
            for (int b = 0; b < 2; ++b)
#pragma unroll
                for (int m = 0; m < 4; ++m)
#pragma unroll
                    for (int n = 0; n < 2; ++n) acc[a][b][m][n] = (f32x4){0.f, 0.f, 0.f, 0.f};
        cur = nxt; cA = nA; cB = nB; ++ui;
        if (wr == 1) PG8_BAR;
    }
    PG8_WAIT_V(0);
    PG8_BAR;
#undef PG8_SA
#undef PG8_SB
#undef PG8_STAGE
#undef PG8_LDA
#undef PG8_LDB
#undef PG8_MMA
#undef PG8_WAIT_V
#undef PG8_WAIT_L
#undef PG8_BAR
#undef PG8_SCHED
}
}

struct Frame {
    LAS unsigned char* lds; int tid, lane, wave, vcu, G, gw, NGW;
};


typedef pg8::Unit Unit;
DI void st_bf16x8(bf16_t* p, const f32x4& a, const f32x4& b) { u32x4 w; w.x = cvtpk(a[0], a[1]); w.y = cvtpk(a[2], a[3]); w.z = cvtpk(b[0], b[1]); w.w = cvtpk(b[2], b[3]); *(u32x4*)p = w; }

struct EpiNull { static constexpr bool PERM = true; static constexpr bool AROW4 = false; float* sink; DI void operator()(f32x4 (&acc)[2][2][4][2], const Unit& u, int wr, int wc, int fr, int fq) const {
        if (acc[0][0][0][0][0] == 1.2345e33f) *sink = 1.f; } };
struct EpiIn0 {
    static constexpr bool PERM = true; static constexpr bool AROW4 = false;
    bf16_t *Q, *KS, *VS, *KC, *VC, *GU, *GV; float *ck, *cv, *rowsq; const float* rope;
    DI void operator()(f32x4 (&acc)[2][2][4][2], const Unit& u, int wr, int wc, int fr, int fq) const {
        asm volatile("" : "+v"(fr), "+v"(fq));
        const int region = u.pn >> 1;
        const bool smp = (u.pm >= T_CTX / 256);
        const int cbase = (u.pn & 1) * 256 + wc * 64 + fq * 8;
#pragma unroll
        for (int ai = 0; ai < 2; ++ai)
#pragma unroll
            for (int m = 0; m < 4; ++m) {
                const int row = u.pm * 256 + ai * 128 + wr * 64 + m * 16 + fr;
                const int srow = row - T_CTX, sb = srow >> 12, pos = srow & 4095;
                float ss = 0.f;
#pragma unroll
                for (int bj = 0; bj < 2; ++bj) {
                    const int col = cbase + bj * 32;
                    f32x4 v0 = acc[ai][bj][m][0], v1 = acc[ai][bj][m][1];
                    if (region <= 1) {
                        if (smp) {
                            f32x4 p0, p1;
#pragma unroll
                            for (int i = 0; i < 4; ++i) { p0[i] = __shfl_xor(v0[i], 32); p1[i] = __shfl_xor(v1[i], 32); }
                            const int coord = (bj & 1) ? (pos & 63) : (pos >> 6);
                            const float* tc = rope + coord * 16 + (fq & 1) * 8; const float* tsn = tc + 1024;
                            const f32x4 c0 = *(const f32x4*)tc, c1 = *(const f32x4*)(tc + 4), s0 = *(const f32x4*)tsn, s1 = *(const f32x4*)(tsn + 4);
                            const float sg = (fq & 2) ? 1.f : -1.f;
                            v0 = v0 * c0 + (p0 * s0) * sg; v1 = v1 * c1 + (p1 * s1) * sg;
                        }
                        if (region == 0) { v0 = v0 * ATT_C2; v1 = v1 * ATT_C2; st_bf16x8(Q + (size_t)row * 512 + col, v0, v1); }
                        else if (smp) st_bf16x8(KS + ((size_t)sb * LKS + PAST + pos) * 512 + col, v0, v1);
                        else { float* o = ck + (size_t)row * 512 + col; *(f32x4*)o = v0; *(f32x4*)(o + 4) = v1; st_bf16x8(KC + (size_t)row * 512 + col, v0, v1); }
                    } else if (region == 2) {
                        if (smp) st_bf16x8(VS + ((size_t)sb * LKS + PAST + pos) * 512 + col, v0, v1);
                        else { float* o = cv + (size_t)row * 512 + col; *(f32x4*)o = v0; *(f32x4*)(o + 4) = v1; st_bf16x8(VC + (size_t)row * 512 + col, v0, v1); }
                    } else {
#pragma unroll
                        for (int i = 0; i < 4; ++i) { v0[i] = gelu_f(v0[i]); v1[i] = gelu_f(v1[i]); }
                        if (region == 3) st_bf16x8(GU + (size_t)row * 512 + col, v0, v1);
                        else { st_bf16x8(GV + (size_t)row * 512 + col, v0, v1);
#pragma unroll
                            for (int i = 0; i < 4; ++i) ss += v0[i] * v0[i] + v1[i] * v1[i]; }
                    }
                }
                if (region == 4) { ss += __shfl_xor(ss, 16); ss += __shfl_xor(ss, 32); if (fq == 0) atomicAdd(rowsq + row, ss); }
            }
    }
};

DI f32x4 bf16x4_lo(const u32x4& w) { return (f32x4){__uint_as_float(w.x << 16), __uint_as_float(w.x & 0xffff0000u), __uint_as_float(w.y << 16), __uint_as_float(w.y & 0xffff0000u)}; }
DI f32x4 bf16x4_hi(const u32x4& w) { return (f32x4){__uint_as_float(w.z << 16), __uint_as_float(w.z & 0xffff0000u), __uint_as_float(w.w << 16), __uint_as_float(w.w & 0xffff0000u)}; }
template <bool NEXT, bool BF32> struct EpiRes {
    static constexpr bool PERM = true; static constexpr bool AROW4 = false;
    const float* base_c; const float* base_s; const bf16_t* xb; bf16_t* xo; const float* mod; int gate_off;
    bf16_t* Hn; const float* nw; const float* modn; int sc_off; float* rsq;
    DI void operator()(f32x4 (&acc)[2][2][4][2], const Unit& u, int wr, int wc, int fr, int fq) const {
        asm volatile("" : "+v"(fr), "+v"(fq));
        const int row0 = u.pm * 256 + wr * 64 + fr, col0 = u.pn * 256 + wc * 64 + 8 * fq;
        const bool smp = (u.pm >= T_CTX / 256);
        const int cond = smp ? ((u.pm * 256 - T_CTX) >> 12) : 8;
        const float* g = mod + cond * 6144 + gate_off + col0;
        f32x4 gv[2][2], nv[2][2];
#pragma unroll
        for (int bj = 0; bj < 2; ++bj)
#pragma unroll
            for (int n = 0; n < 2; ++n) { gv[bj][n] = *(const f32x4*)(g + bj * 32 + n * 4);
                if (NEXT) nv[bj][n] = *(const f32x4*)(nw + col0 + bj * 32 + n * 4) * (*(const f32x4*)(modn + cond * 6144 + sc_off + col0 + bj * 32 + n * 4) + 1.f); }
#pragma unroll
        for (int ai = 0; ai < 2; ++ai)
#pragma unroll
            for (int m = 0; m < 4; ++m) {
                const int row = row0 + ai * 128 + m * 16;
                f32x4 b[2][2];
#pragma unroll
                for (int bj = 0; bj < 2; ++bj) {
                    if (BF32) { const float* bp = (smp ? base_s + (size_t)(row - T_CTX) * D : base_c + (size_t)row * D) + col0 + bj * 32; b[bj][0] = *(const f32x4*)bp; b[bj][1] = *(const f32x4*)(bp + 4); }
                    else { const u32x4 w = *(const u32x4*)(xb + (size_t)row * D + col0 + bj * 32); b[bj][0] = bf16x4_lo(w); b[bj][1] = bf16x4_hi(w); } }
                float ss = 0.f;
#pragma unroll
                for (int bj = 0; bj < 2; ++bj) {
                    const f32x4 x0 = b[bj][0] + gv[bj][0] * acc[ai][bj][m][0], x1 = b[bj][1] + gv[bj][1] * acc[ai][bj][m][1];
                    st_bf16x8(xo + (size_t)row * D + col0 + bj * 32, x0, x1);
                    if (NEXT) { ss += ((x0.x * x0.x + x0.y * x0.y) + (x0.z * x0.z + x0.w * x0.w)) + ((x1.x * x1.x + x1.y * x1.y) + (x1.z * x1.z + x1.w * x1.w));
                        st_bf16x8(Hn + (size_t)row * D + col0 + bj * 32, x0 * nv[bj][0], x1 * nv[bj][1]); } }
                if (NEXT) { ss += __shfl_xor(ss, 16); ss += __shfl_xor(ss, 32); if (fq == 0) atomicAdd(rsq + row, ss); }
            }
    }
};

template <int CTRL> DI float dppf(float old, float src) { return __int_as_float(__builtin_amdgcn_update_dpp(__float_as_int(old), __float_as_int(src), CTRL, 0xf, 0xf, false)); }
template <int CTRL> DI float dppm(float src) { return __int_as_float(__builtin_amdgcn_mov_dpp(__float_as_int(src), CTRL, 0xf, 0xf, false)); }
constexpr int DPP_SHL1 = 0x101, DPP_SHR1 = 0x111, DPP_ROR1 = 0x121, DPP_ROR15 = 0x12F;
constexpr int EDS_OFF = 131072;
struct EpiUpConv {
    static constexpr bool PERM = true; static constexpr bool AROW4 = true;
    bf16_t* U; float* edge; const float* cw; const float* cb; LAS float* eds; const float* rsq; const float* bias;
    DI void operator()(f32x4 (&acc)[2][2][4][2], const Unit& u, int wr, int wc, int fr, int fq) const {
        asm volatile("" : "+v"(fr), "+v"(fq));
        const int col0 = u.pn * 128 + wc * 32 + fq * 8, ecol = wc * 32 + fq * 8;
        {
            const int cond = (u.pm >= T_CTX / 256) ? ((u.pm * 256 - T_CTX) >> 12) : 8;
            const float* bp = bias + cond * (2 * DFF) + col0;
            const f32x4 ba0 = *(const f32x4*)bp, ba1 = *(const f32x4*)(bp + 4), bg0 = *(const f32x4*)(bp + DFF), bg1 = *(const f32x4*)(bp + DFF + 4);
#pragma unroll
            for (int ai = 0; ai < 2; ++ai)
#pragma unroll
                for (int m = 0; m < 4; ++m) { const float rstd = rsqrtf(rsq[u.pm * 256 + ai * 128 + wr * 64 + 4 * fr + m] * (1.f / D) + EPS);
                    acc[ai][0][m][0] = acc[ai][0][m][0] * rstd + ba0; acc[ai][0][m][1] = acc[ai][0][m][1] * rstd + ba1;
                    acc[ai][1][m][0] = acc[ai][1][m][0] * rstd + bg0; acc[ai][1][m][1] = acc[ai][1][m][1] * rstd + bg1; }
        }
#pragma unroll
        for (int ai = 0; ai < 2; ++ai) { const int blk = ai * 2 + wr;
            if (fr == 0)  { *(LAS f32x4*)(eds + (blk * 2 + 0) * 128 + ecol) = acc[ai][0][0][0]; *(LAS f32x4*)(eds + (blk * 2 + 0) * 128 + ecol + 4) = acc[ai][0][0][1]; }
            if (fr == 15) { *(LAS f32x4*)(eds + (blk * 2 + 1) * 128 + ecol) = acc[ai][0][3][0]; *(LAS f32x4*)(eds + (blk * 2 + 1) * 128 + ecol + 4) = acc[ai][0][3][1]; } }
        f32x4 w0[2], w1[2], w2[2], bb[2];
#pragma unroll
        for (int n = 0; n < 2; ++n) { w0[n] = *(const f32x4*)(cw + col0 + 4 * n); w1[n] = *(const f32x4*)(cw + DFF + col0 + 4 * n); w2[n] = *(const f32x4*)(cw + 2 * DFF + col0 + 4 * n); bb[n] = *(const f32x4*)(cb + col0 + 4 * n); }
        const bool smp = u.pm >= T_CTX / 256;
        const bool seq_top = !smp || (((u.pm - T_CTX / 256) & 15) == 0), seq_bot = !smp || (((u.pm - T_CTX / 256) & 15) == 15);
        const f32x4 z4 = {0.f, 0.f, 0.f, 0.f};
        f32x4 pe[2][2] = {{z4, z4}, {z4, z4}}, ne[2][2] = {{z4, z4}, {z4, z4}};
#define UPC_GROUP(AI, M) do { \
                const size_t row = (size_t)(u.pm * 256 + (AI) * 128 + wr * 64 + 4 * fr + (M)); \
                f32x4 tt[2], oo[2]; \
                _Pragma("unroll") for (int n = 0; n < 2; ++n) { \
                    const f32x4 a = acc[AI][0][M][n], g = acc[AI][1][M][n]; f32x4 pv, nv; \
                    _Pragma("unroll") for (int i = 0; i < 4; ++i) { \
                        pv[i] = ((M) > 0) ? acc[AI][0][(M) > 0 ? (M) - 1 : 0][n][i] : dppf<DPP_SHR1>(pe[AI][n][i], acc[AI][0][3][n][i]);     \
                        nv[i] = ((M) < 3) ? acc[AI][0][(M) < 3 ? (M) + 1 : 3][n][i] : dppf<DPP_SHL1>(ne[AI][n][i], acc[AI][0][0][n][i]); }   \
                    tt[n] = w0[n] * pv + w1[n] * a + w2[n] * nv + bb[n]; \
                    { const f32x2 lo = gelu_gate2((f32x2){tt[n][0], tt[n][1]}, (f32x2){g[0], g[1]}), hi = gelu_gate2((f32x2){tt[n][2], tt[n][3]}, (f32x2){g[2], g[3]}); \
                      oo[n][0] = lo.x; oo[n][1] = lo.y; oo[n][2] = hi.x; oo[n][3] = hi.y; } \
                } \
                st_bf16x8(U + row * DFF + col0, oo[0], oo[1]); \
                  \
                if ((M) == 0 && (AI) * 2 + wr == 0 && !seq_top && fr == 0) { float* e = edge + ((size_t)(u.pm * 2 + 0) * 3) * DFF + col0; \
                    *(f32x4*)e = tt[0]; *(f32x4*)(e + 4) = tt[1]; *(f32x4*)(e + DFF) = acc[AI][0][M][0]; *(f32x4*)(e + DFF + 4) = acc[AI][0][M][1]; *(f32x4*)(e + 2 * DFF) = acc[AI][1][M][0]; *(f32x4*)(e + 2 * DFF + 4) = acc[AI][1][M][1]; } \
                if ((M) == 3 && (AI) * 2 + wr == 3 && !seq_bot && fr == 15) { float* e = edge + ((size_t)(u.pm * 2 + 1) * 3) * DFF + col0; \
                    *(f32x4*)e = tt[0]; *(f32x4*)(e + 4) = tt[1]; *(f32x4*)(e + DFF) = acc[AI][0][M][0]; *(f32x4*)(e + DFF + 4) = acc[AI][0][M][1]; *(f32x4*)(e + 2 * DFF) = acc[AI][1][M][0]; *(f32x4*)(e + 2 * DFF + 4) = acc[AI][1][M][1]; } \
            } while (0)
        UPC_GROUP(0, 1); UPC_GROUP(0, 2); UPC_GROUP(1, 1); UPC_GROUP(1, 2);
        asm volatile("s_waitcnt lgkmcnt(0)" ::: "memory"); __builtin_amdgcn_s_barrier(); asm volatile("" ::: "memory");
#pragma unroll
        for (int ai = 0; ai < 2; ++ai) { const int blk = ai * 2 + wr;
#pragma unroll
            for (int n = 0; n < 2; ++n) { pe[ai][n] = (blk > 0) ? *(const LAS f32x4*)(eds + ((blk - 1) * 2 + 1) * 128 + ecol + 4 * n) : z4;
                                          ne[ai][n] = (blk < 3) ? *(const LAS f32x4*)(eds + ((blk + 1) * 2 + 0) * 128 + ecol + 4 * n) : z4; } }
        UPC_GROUP(0, 0); UPC_GROUP(0, 3); UPC_GROUP(1, 0); UPC_GROUP(1, 3);
#undef UPC_GROUP
    }
};
DI void ffn_fix_row(bf16_t* U, const float* edge, const float* cw, int pm, int side, int c) {
    const float* mine = edge + ((size_t)(pm * 2 + (side ? 0 : 1)) * 3) * DFF + c;
    const float* other = edge + ((size_t)((side ? pm - 1 : pm + 1) * 2 + (side ? 1 : 0)) * 3) * DFF + c;
    const float* w = cw + (side ? 0 : 2 * DFF) + c;
    float o[8];
#pragma unroll
    for (int i = 0; i < 8; ++i) o[i] = gelu_f(mine[i] + w[i] * other[DFF + i]) * mine[2 * DFF + i];
    const size_t row = (size_t)pm * 256 + (side ? 0 : 255);
    u32x4 pk; pk.x = cvtpk(o[0], o[1]); pk.y = cvtpk(o[2], o[3]); pk.z = cvtpk(o[4], o[5]); pk.w = cvtpk(o[6], o[7]);
    *(u32x4*)(U + row * DFF + c) = pk;
}
DI void ffn_fixup_own(const Frame& F, bf16_t* U, const float* edge, const float* cw, int c) {
    for (int rnd = 0; ; ++rnd) {
        const long L = (long)rnd * F.G + c; if (L >= (T_ALL / 256) * 4) break;
        const int x = (int)(L % 8), off = (int)(L / 8), pm = 8 * (off >> 2) + x;
        if (pm < T_CTX / 256) continue;
        const int k = (pm - T_CTX / 256) & 15;
        for (int it = F.tid; it < 2 * (DFF / 8); it += 512) { const int side = it / (DFF / 8), ch = it % (DFF / 8);
            if (side ? (k != 0) : (k != 15)) ffn_fix_row(U, edge, cw, pm, side, ch * 8); }
    }
    asm volatile("s_waitcnt vmcnt(0)" ::: "memory");
    __syncthreads();
}

struct EpiIn1 {
    static constexpr bool PERM = true; static constexpr bool AROW4 = false;
    bf16_t *XM, *OG; float* gates; const float* bg; const float* rsq; const float* bias;
    DI void operator()(f32x4 (&acc)[2][2][4][2], const Unit& u, int wr, int wc, int fr, int fq) const {
        asm volatile("" : "+v"(fr), "+v"(fq));
        const int region = u.pn >> 2;
        { const int cond = (u.pm >= T_CTX / 256) ? ((u.pm * 256 - T_CTX) >> 12) : 8;
          const float* bp = bias + cond * NIN1P + u.pn * 256 + wc * 64 + fq * 8;
          const f32x4 b00 = *(const f32x4*)bp, b01 = *(const f32x4*)(bp + 4), b10 = *(const f32x4*)(bp + 32), b11 = *(const f32x4*)(bp + 36);
#pragma unroll
          for (int ai = 0; ai < 2; ++ai)
#pragma unroll
              for (int m = 0; m < 4; ++m) { const float rstd = rsqrtf(rsq[u.pm * 256 + ai * 128 + wr * 64 + m * 16 + fr] * (1.f / D) + EPS);
                  acc[ai][0][m][0] = acc[ai][0][m][0] * rstd + b00; acc[ai][0][m][1] = acc[ai][0][m][1] * rstd + b01;
                  acc[ai][1][m][0] = acc[ai][1][m][0] * rstd + b10; acc[ai][1][m][1] = acc[ai][1][m][1] * rstd + b11; } }
#pragma unroll
        for (int ai = 0; ai < 2; ++ai)
#pragma unroll
            for (int m = 0; m < 4; ++m) {
                const size_t row = (size_t)(u.pm * 256 + ai * 128 + wr * 64 + m * 16 + fr);
#pragma unroll
                for (int bj = 0; bj < 2; ++bj) {
                    const int col = (u.pn & 3) * 256 + wc * 64 + bj * 32 + fq * 8;
                    f32x4 v0 = acc[ai][bj][m][0], v1 = acc[ai][bj][m][1];
                    if (region == 0) st_bf16x8(XM + row * D + col, v0, v1);
                    else if (region == 1) {
#pragma unroll
                        for (int i = 0; i < 4; ++i) { v0[i] = sigmoid_f(v0[i]); v1[i] = sigmoid_f(v1[i]); }
                        st_bf16x8(OG + row * D + col, v0, v1);
                    } else if (bj == 0 && wc == 0 && fq < 2) {
                        const f32x4 b0 = *(const f32x4*)(bg + 8 * fq), b1 = *(const f32x4*)(bg + 8 * fq + 4);
                        v0 = v0 + b0; v1 = v1 + b1;
                        if (fq == 0) {
#pragma unroll
                            for (int i = 0; i < 4; ++i) v1[i] = logsigmoid_f(v1[i]);
                        } else {
#pragma unroll
                            for (int i = 0; i < 4; ++i) v1[i] = logsigmoid_f(v1[i]);
                        }
                        float* o = gates + row * 16 + 8 * fq; *(f32x4*)o = v0; *(f32x4*)(o + 4) = v1;
                    }
                }
            }
    }
};

struct QkvOrder {
    const bf16_t *XC, *XM, *W; int nwg, G, c;
    DI void init(const bf16_t* xc, const bf16_t* xm, const bf16_t* w, int G_, int c_) { XC = xc; XM = xm; W = w; nwg = (T_ALL / 256) * 12; G = G_; c = c_; }
    DI bool next(int i, Unit& u) const {
        const long L = (long)i * G + c; if (L >= nwg) return false;
        const int wgid = (int)(L % 8) * (nwg / 8) + (int)(L / 8);
        u.pm = wgid / 12; u.aux = wgid % 12; u.pn = 0; return true;
    }
    DI const char* a_ptr(const Unit& u) const { const int head = u.aux / 3, j = u.aux % 3; return (const char*)((j == 2 ? XM : XC) + (size_t)u.pm * 256 * D + head * 256); }
    DI const char* b_ptr(const Unit& u) const { return (const char*)(W + (size_t)u.aux * 65536); }
};
struct EpiQkv1 {
    static constexpr bool PERM = true; static constexpr bool AROW4 = false;
    bf16_t *Q1, *K1, *V1;
    DI void operator()(f32x4 (&acc)[2][2][4][2], const Unit& u, int wr, int wc, int fr, int fq) const {
        asm volatile("" : "+v"(fr), "+v"(fq));
        const int head = u.aux / 3, j = u.aux % 3;
        bf16_t* O = (j == 0) ? Q1 : (j == 1) ? K1 : V1; const float sc = (j == 1) ? 0.0625f : 1.f;
#pragma unroll
        for (int ai = 0; ai < 2; ++ai)
#pragma unroll
            for (int m = 0; m < 4; ++m) {
                const size_t row = (size_t)(u.pm * 256 + ai * 128 + wr * 64 + m * 16 + fr);
#pragma unroll
                for (int bj = 0; bj < 2; ++bj) st_bf16x8(O + row * D + head * 256 + wc * 64 + bj * 32 + fq * 8, acc[ai][bj][m][0] * sc, acc[ai][bj][m][1] * sc);
            }
    }
};

template <int MAP> DI void tr_item(const float* W, int K, int N, bf16_t* WT, LAS float* scr, int item, int lane) {
    const int nblk = (N + 31) / 32, kb = item / nblk, nb = item % nblk, k0 = 64 * kb, n0 = 32 * nb;
    const int ncol = n0 + (lane & 31);
#pragma unroll 8
    for (int i = 0; i < 32; ++i) { const int kk = 2 * i + (lane >> 5); scr[kk * 33 + (lane & 31)] = (ncol < N) ? W[(size_t)(k0 + kk) * N + ncol] : 0.f; }
    LDS_WAIT(); asm volatile("" ::: "memory");
    int d0 = n0;
    if (MAP == 1) { const int j = (n0 >= DFF) ? n0 - DFF : n0; d0 = (j >> 7) * 256 + ((j >> 5) & 3) * 64 + ((n0 >= DFF) ? 32 : 0) + (j & 31); }
    const int c = lane & 7;
#pragma unroll
    for (int j = 0; j < 4; ++j) { const int n = (lane >> 3) + 8 * j; const LAS float* s = scr + (8 * c) * 33 + n;
        u32x4 o; o.x = cvtpk(s[0 * 33], s[1 * 33]); o.y = cvtpk(s[2 * 33], s[3 * 33]); o.z = cvtpk(s[4 * 33], s[5 * 33]); o.w = cvtpk(s[6 * 33], s[7 * 33]);
        *(u32x4*)(WT + (size_t)(d0 + n) * K + k0 + 8 * c) = o; }
    LDS_WAIT(); asm volatile("" ::: "memory");
}
template <int MAP> DI void tr_matrix(const Frame& F, const float* W, int K, int N, bf16_t* WT, int& rot) {
    LAS float* scr = (LAS float*)(F.lds + 65536 + F.wave * 8704);
    const int nitems = (K / 64) * ((N + 31) / 32);
    int first = F.gw - rot; if (first < 0) first += F.NGW;
    for (int it = first; it < nitems; it += F.NGW) tr_item<MAP>(W, K, N, WT, scr, it, F.lane);
    rot = (rot + nitems) % F.NGW;
}
DI void gemv9_item(const Frame& F, LAS float* coef  , const float* W, int ldw, int N, int n0, const float* addv, float* out, int ldo) {
    LAS float* red = (LAS float*)(F.lds + 36864);
    const int cq = F.lane & 15, kq = F.lane >> 4;
    const int n = n0 + 4 * cq; const bool ok = n < N;
    const float* Wp = W + (ok ? n : 0);
    f32x4 acc[9];
#pragma unroll
    for (int ci = 0; ci < 9; ++ci) acc[ci] = (f32x4){0.f, 0.f, 0.f, 0.f};
    const int kb = F.wave * 128 + kq;
#pragma unroll 8
    for (int k = 0; k < 128; k += 4) { const f32x4 w = *(const f32x4*)(Wp + (size_t)(kb + k) * ldw);
#pragma unroll
        for (int ci = 0; ci < 9; ++ci) acc[ci] += w * coef[ci * 1024 + kb + k]; }
#pragma unroll
    for (int ci = 0; ci < 9; ++ci) {
#pragma unroll
        for (int i = 0; i < 4; ++i) { float v = acc[ci][i]; v += __shfl_xor(v, 16); v += __shfl_xor(v, 32); acc[ci][i] = v; }
        if (kq == 0) *(LAS f32x4*)(red + (F.wave * 9 + ci) * 64 + 4 * cq) = acc[ci]; }
    __syncthreads();
    for (int i = F.tid; i < 9 * 64; i += 512) { float sacc = 0.f;
#pragma unroll
        for (int w = 0; w < 8; ++w) sacc += red[w * 576 + i];
        const int ci = i >> 6, nn = n0 + (i & 63); if (nn < N) out[(size_t)ci * ldo + nn] = sacc + (addv ? addv[nn] : 0.f); }
    __syncthreads();
}
DI void mod_gemv(const Frame& F, const Params& P, float* MOD) {
    if (F.vcu >= 192) return;
    LAS float* sil = (LAS float*)F.lds;
    for (int i = F.tid; i < 9 * 1024; i += 512) { const int ci = i >> 10, k = i & 1023; const float v = (ci < 8) ? P.in[I_C][ci * 1024 + k] : P.in[I_CCTX][k]; sil[i] = silu_f(v); }
    __syncthreads();
    const int item = F.vcu, l = item / 96, n0 = (item % 96) * 64;
    gemv9_item(F, sil, P.in[I_WMOD] + (size_t)l * 1024 * 6144, 6144, 6144, n0, P.in[I_BMOD] + l * 6144, MOD + (size_t)l * 9 * 6144, 6144);
}
DI void bias_gemv(const Frame& F, const Params& P, int first, int stride) {
  for (int item = first; item < 209; item += stride) {
    const float* MOD = (const float*)(P.ws + WS_MOD); float* BIAS = (float*)(P.ws + WS_BIAS);
    const int tbl = item < 88 ? 0 : (item < 121 ? 1 : 2), blk = item < 88 ? item : (item < 121 ? item - 88 : item - 121);
    const float* sh = MOD + (tbl == 0 ? 0 : 9 * 6144) + (tbl == 1 ? 0 : 3072);
    LAS float* coef = (LAS float*)F.lds;
    for (int i = F.tid; i < 9 * 1024; i += 512) coef[i] = sh[(size_t)(i >> 10) * 6144 + (i & 1023)];
    __syncthreads();
    if (tbl == 1) gemv9_item(F, coef, P.in[I_WIN1], NIN1, NIN1, blk * 64, nullptr, BIAS + BIAS_IN1, NIN1P);
    else gemv9_item(F, coef, P.in[I_WUP] + (tbl == 2 ? (size_t)D * 2 * DFF : 0), 2 * DFF, 2 * DFF, blk * 64, nullptr, BIAS + (tbl == 2 ? BIAS_UP1 : BIAS_UP0), 2 * DFF);
  }
}
DI void modulate_rows(const Frame& F, const float* xc, const float* xs, const float* nw, const float* modl, int sh_off, int sc_off, bf16_t* H) {
    for (int grp = F.gw; grp < T_ALL / 4; grp += F.NGW) {
        const int row0 = grp * 4; const bool smp = row0 >= T_CTX; const int cond = smp ? ((row0 - T_CTX) >> 12) : 8;
        const f32x4* xr = (const f32x4*)(smp ? xs + (size_t)(row0 - T_CTX) * D : xc + (size_t)row0 * D) + F.lane;
        f32x4 v[4][4]; float ss[4];
#pragma unroll
        for (int rr = 0; rr < 4; ++rr)
#pragma unroll
            for (int j = 0; j < 4; ++j) v[rr][j] = xr[rr * 256 + 64 * j];
#pragma unroll
        for (int rr = 0; rr < 4; ++rr) { float t = 0.f;
#pragma unroll
            for (int j = 0; j < 4; ++j) t += (v[rr][j].x * v[rr][j].x + v[rr][j].y * v[rr][j].y) + (v[rr][j].z * v[rr][j].z + v[rr][j].w * v[rr][j].w);
            ss[rr] = t; }
#pragma unroll
        for (int o = 1; o < 64; o <<= 1) {
#pragma unroll
            for (int rr = 0; rr < 4; ++rr) ss[rr] += __shfl_xor(ss[rr], o); }
        const float* mp = modl + cond * 6144;
#pragma unroll
        for (int j = 0; j < 4; ++j) { const int c = 4 * (F.lane + 64 * j);
            const f32x4 w = *(const f32x4*)(nw + c), sc = *(const f32x4*)(mp + sc_off + c), sh = *(const f32x4*)(mp + sh_off + c);
            const f32x4 wg = w * (sc + 1.f);
#pragma unroll
            for (int rr = 0; rr < 4; ++rr) { const float rstd = rsqrtf(ss[rr] * (1.f / D) + EPS); const f32x4 y = (v[rr][j] * rstd) * wg + sh;
                u32x2 pk; pk.x = cvtpk(y.x, y.y); pk.y = cvtpk(y.z, y.w); *((u32x2*)(H + (size_t)(row0 + rr) * D) + F.lane + 64 * j) = pk; } }
    }
}
DI void final_norm_rows(const Frame& F, const bf16_t* xb, float* y, const float* w, int row_lo, int row_hi, int wave_idx, int nwaves) {
    for (int grp = row_lo / 4 + wave_idx; grp < row_hi / 4; grp += nwaves) {
        const u32x2* xr = (const u32x2*)(xb + (size_t)grp * 4 * D) + F.lane;
        f32x4* yr = (f32x4*)(y + (size_t)grp * 4 * D) + F.lane;
        f32x4 v[4][4]; float ss[4];
#pragma unroll
        for (int rr = 0; rr < 4; ++rr)
#pragma unroll
            for (int j = 0; j < 4; ++j) { const u32x2 t = xr[rr * 256 + 64 * j];
                v[rr][j] = (f32x4){__uint_as_float(t.x << 16), __uint_as_float(t.x & 0xffff0000u), __uint_as_float(t.y << 16), __uint_as_float(t.y & 0xffff0000u)}; }
#pragma unroll
        for (int rr = 0; rr < 4; ++rr) { float t = 0.f;
#pragma unroll
            for (int j = 0; j < 4; ++j) t += (v[rr][j].x * v[rr][j].x + v[rr][j].y * v[rr][j].y) + (v[rr][j].z * v[rr][j].z + v[rr][j].w * v[rr][j].w);
            ss[rr] = t; }
#pragma unroll
        for (int o = 1; o < 64; o <<= 1) {
#pragma unroll
            for (int rr = 0; rr < 4; ++rr) ss[rr] += __shfl_xor(ss[rr], o); }
#pragma unroll
        for (int j = 0; j < 4; ++j) { const f32x4 ww = *(const f32x4*)(w + 4 * (F.lane + 64 * j));
#pragma unroll
            for (int rr = 0; rr < 4; ++rr) yr[rr * 256 + 64 * j] = (v[rr][j] * rsqrtf(ss[rr] * (1.f / D) + EPS)) * ww; }
    }
}

DI bool seq_first(int row) { return row < T_CTX ? ((row & 255) == 0) : (((row - T_CTX) & 4095) == 0); }
DI bool seq_last(int row) { return row < T_CTX ? ((row & 255) == 255) : (((row - T_CTX) & 4095) == 4095); }
DI void unpack8(const u32x4& w, float (&f)[8]) { f[0] = bflo(w.x); f[1] = bfhi(w.x); f[2] = bflo(w.y); f[3] = bfhi(w.y); f[4] = bflo(w.z); f[5] = bfhi(w.z); f[6] = bflo(w.w); f[7] = bfhi(w.w); }

DI void mconv_rows(const Frame& F, const bf16_t* XM, bf16_t* XC, const float* cw, const float* cb) {
    for (int grp = F.gw; grp < T_ALL / 4; grp += F.NGW) {
        const int row0 = grp * 4; const bool hp = !seq_first(row0), hn = !seq_last(row0 + 3);
        const u32x4 z = {0u, 0u, 0u, 0u};
#pragma unroll
        for (int j = 0; j < 2; ++j) {
            const int c = (F.lane + 64 * j) * 8;
            const bf16_t* ar = XM + (size_t)row0 * D + c;
            u32x4 a[6];
            a[0] = hp ? *(const u32x4*)(ar - D) : z; a[5] = hn ? *(const u32x4*)(ar + 4 * D) : z;
#pragma unroll
            for (int rr = 0; rr < 4; ++rr) a[1 + rr] = *(const u32x4*)(ar + rr * D);
            float w0[8], w1[8], w2[8], bb[8];
#pragma unroll
            for (int i = 0; i < 8; i += 4) { *(f32x4*)(w0 + i) = *(const f32x4*)(cw + c + i); *(f32x4*)(w1 + i) = *(const f32x4*)(cw + D + c + i); *(f32x4*)(w2 + i) = *(const f32x4*)(cw + 2 * D + c + i); *(f32x4*)(bb + i) = *(const f32x4*)(cb + c + i); }
            float f[6][8];
#pragma unroll
            for (int q = 0; q < 6; ++q) unpack8(a[q], f[q]);
#pragma unroll
            for (int rr = 0; rr < 4; ++rr) { float o[8];
#pragma unroll
                for (int i = 0; i < 8; ++i) o[i] = silu_f(w0[i] * f[rr][i] + w1[i] * f[rr + 1][i] + w2[i] * f[rr + 2][i] + bb[i]);
                u32x4 w; w.x = cvtpk(o[0], o[1]); w.y = cvtpk(o[2], o[3]); w.z = cvtpk(o[4], o[5]); w.w = cvtpk(o[6], o[7]);
                *(u32x4*)(XC + (size_t)(row0 + rr) * D + c) = w; }
        }
    }
}
DI void mpost_rows(const Frame& F, const bf16_t* HF, const bf16_t* HB, const bf16_t* OG, const bf16_t* XC, const float* hnw, const float* skip, bf16_t* Y) {
    for (int grp = F.gw; grp < T_ALL / 4; grp += F.NGW) {
        const size_t rb0 = (size_t)grp * 4 * D;
#pragma unroll
        for (int hd = 0; hd < 4; ++hd) {
            const int c = hd * 256 + 4 * F.lane;
            u32x2 a[4], b[4], g[4], x[4]; float hs[4][4], ss[4];
#pragma unroll
            for (int rr = 0; rr < 4; ++rr) { const size_t o = rb0 + (size_t)rr * D + c; a[rr] = *(const u32x2*)(HF + o); b[rr] = *(const u32x2*)(HB + o); g[rr] = *(const u32x2*)(OG + o); x[rr] = *(const u32x2*)(XC + o); }
#pragma unroll
            for (int rr = 0; rr < 4; ++rr) { hs[rr][0] = bflo(a[rr].x) + bflo(b[rr].x); hs[rr][1] = bfhi(a[rr].x) + bfhi(b[rr].x); hs[rr][2] = bflo(a[rr].y) + bflo(b[rr].y); hs[rr][3] = bfhi(a[rr].y) + bfhi(b[rr].y);
                ss[rr] = (hs[rr][0] * hs[rr][0] + hs[rr][1] * hs[rr][1]) + (hs[rr][2] * hs[rr][2] + hs[rr][3] * hs[rr][3]); }
#pragma unroll
            for (int o = 1; o < 64; o <<= 1) {
#pragma unroll
                for (int rr = 0; rr < 4; ++rr) ss[rr] += __shfl_xor(ss[rr], o); }
            const f32x4 w = *(const f32x4*)(hnw + c), sk = *(const f32x4*)(skip + c);
#pragma unroll
            for (int rr = 0; rr < 4; ++rr) { const float rstd = rsqrtf(ss[rr] * (1.f / 256.f) + EPS);
                const float og[4] = {bflo(g[rr].x), bfhi(g[rr].x), bflo(g[rr].y), bfhi(g[rr].y)}, xc[4] = {bflo(x[rr].x), bfhi(x[rr].x), bflo(x[rr].y), bfhi(x[rr].y)};
                float y[4];
#pragma unroll
                for (int i = 0; i < 4; ++i) y[i] = og[i] * (hs[rr][i] * rstd * w[i] + sk[i] * xc[i]);
                u32x2 pk; pk.x = cvtpk(y[0], y[1]); pk.y = cvtpk(y[2], y[3]);
                *(u32x2*)(Y + rb0 + (size_t)rr * D + c) = pk; }
        }
    }
}
DI void p9_weights(const Frame& F, const Params& P, int& rot) {
    unsigned char* ws = P.ws;
    tr_matrix<0>(F, P.in[I_WIN1], D, NIN1, (bf16_t*)(ws + WS_WIN1), rot);
    tr_matrix<0>(F, P.in[I_WOUT1], D, D, (bf16_t*)(ws + WS_WOUT1), rot);
#pragma unroll 1
    for (int hj = 0; hj < 12; ++hj) { const int head = hj / 3, j = hj % 3; const float* W = P.in[j == 0 ? I_WQ : j == 1 ? I_WK : I_WV] + (size_t)head * 65536;
        tr_matrix<0>(F, W, 256, 256, (bf16_t*)(ws + WS_WQKV1) + (size_t)hj * 65536, rot); }
}
DI void p16_weights(const Frame& F, const Params& P) {
    unsigned char* ws = P.ws; int rot = 0;
    tr_matrix<1>(F, P.in[I_WUP] + (size_t)D * 2 * DFF, D, 2 * DFF, (bf16_t*)(ws + WS_WUP1), rot);
    tr_matrix<0>(F, P.in[I_WDOWN] + (size_t)DFF * D, DFF, D, (bf16_t*)(ws + WS_WDOWN1), rot);
}

DI void p0_prologue(const Frame& F, const Params& P) {
    unsigned char* ws = P.ws;
    mod_gemv(F, P, (float*)(ws + WS_MOD));
    int rot = 192 * 8;
    tr_matrix<0>(F, P.in[I_WIN0], D, NIN0, (bf16_t*)(ws + WS_WIN0), rot);
    tr_matrix<0>(F, P.in[I_WOUT0], D, D, (bf16_t*)(ws + WS_WOUT0), rot);
    tr_matrix<1>(F, P.in[I_WUP], D, 2 * DFF, (bf16_t*)(ws + WS_WUP), rot);
    tr_matrix<0>(F, P.in[I_WDOWN], DFF, D, (bf16_t*)(ws + WS_WDOWN), rot);
    p9_weights(F, P, rot);
    const int gt = F.gw * 64 + F.lane, NGT = F.NGW * 64;
    for (int i = gt; i < 8 * PAST * 64; i += NGT) {
        const int b = i / (PAST * 64), rem = i % (PAST * 64);
        const size_t src = (size_t)i * 8, dst = ((size_t)b * LKS) * 512 + (size_t)rem * 8;
        const f32x4 k0 = *(const f32x4*)(P.in[I_CK] + src), k1 = *(const f32x4*)(P.in[I_CK] + src + 4);
        const f32x4 v0 = *(const f32x4*)(P.in[I_CV] + src), v1 = *(const f32x4*)(P.in[I_CV] + src + 4);
        st_bf16x8((bf16_t*)(ws + WS_KS) + dst, k0, k1); st_bf16x8((bf16_t*)(ws + WS_VS) + dst, v0, v1);
    }
    if (F.vcu == 255) {
        float* rope = (float*)(ws + WS_ROPE);
        for (int i = F.tid; i < 1024; i += 512) { const int coord = i >> 4, f = i & 15; const float inv = exp2f(-(float)f * (13.287712379549449f / 16.f)); const float a = (float)coord * inv;
            rope[i] = __cosf(a); rope[1024 + i] = __sinf(a); }
        if (F.wave == 0) {
            const float d1 = wave_sum(P.in[I_LQ1][F.lane] * P.in[I_LK1][F.lane]), d2 = wave_sum(P.in[I_LQ2][F.lane] * P.in[I_LK2][F.lane]);
            if (F.lane == 0) *(float*)(ws + WS_LAM) = __expf(d1) - __expf(d2) + LAM_INIT;
        }
    }
}
DI void gmlp_item(const Frame& F, const Params& P, int chunk, int g) {
    unsigned char* ws = P.ws;
    constexpr int WSTR = 272, GSTR = 320;
    LAS unsigned char* WT = F.lds; LAS unsigned char* GT = F.lds + 128 * WSTR;
    const int R0 = chunk * 128;
    const float* rowsq = (const float*)(ws + WS_ROWSQ);
    const float* Wsp = P.in[I_WSP] + (size_t)g * 16384;
    const bf16_t* GV = (const bf16_t*)(ws + WS_GV); const bf16_t* GU = (const bf16_t*)(ws + WS_GU);
#pragma unroll
    for (int j = 0; j < 8; ++j) { const int idx = F.tid + 512 * j, t = idx >> 5, s4 = (idx & 31) * 4;
        const f32x4 w = *(const f32x4*)(Wsp + t * 128 + s4); const f32x4 q = *(const f32x4*)(rowsq + R0 + s4);
        u32x2 pk; pk.x = cvtpk(w.x * rsqrtf(q.x * (1.f / 512.f) + EPS), w.y * rsqrtf(q.y * (1.f / 512.f) + EPS)); pk.y = cvtpk(w.z * rsqrtf(q.z * (1.f / 512.f) + EPS), w.w * rsqrtf(q.w * (1.f / 512.f) + EPS));
        *(LAS u32x2*)(WT + t * WSTR + s4 * 2) = pk; }
#pragma unroll
    for (int j = 0; j < 4; ++j) { const int idx = F.tid + 512 * j, s = idx >> 4, ch = idx & 15;
        *(LAS u32x4*)(GT + s * GSTR + ch * 16) = *(const u32x4*)(GV + (size_t)(R0 + s) * 512 + g * 128 + ch * 8); }
    __syncthreads();
    const int lane = F.lane, r = lane & 31, h = lane >> 5, g16 = (lane >> 4) & 1, q4 = (lane & 15) >> 2, p4 = lane & 3, tb = F.wave & 3, chh = F.wave >> 2;
    f32x16 acc[2]; acc[0] = f32x16{}; acc[1] = f32x16{};
#pragma unroll
    for (int ks = 0; ks < 8; ++ks) {
        const bf16x8 af = *(const LAS bf16x8*)(WT + (32 * tb + r) * WSTR + ks * 32 + h * 16);
#pragma unroll
        for (int ct = 0; ct < 2; ++ct) {
            LAS const unsigned char* bp = GT + (16 * ks + 8 * h + q4) * GSTR + (64 * chh + 32 * ct + 16 * g16 + 4 * p4) * 2;
            const bf16x8 bfr = cat8(ldtr(bp), ldtr(bp + 4 * GSTR));
            acc[ct] = MFMA32(bfr, af, acc[ct]);
        }
    }
    const float* gnw = P.in[I_GNW] + g * 128; const float* bsp = P.in[I_BSP] + g * 128;
    bf16_t* MIX = (bf16_t*)(ws + WS_MIX);
    { const int t = 32 * tb + r; const float bt = bsp[t];
      const size_t gro = (size_t)(R0 + t) * 512 + g * 128, mro = (size_t)(R0 + t) * D + 512 + g * 128;
#pragma unroll
      for (int ct = 0; ct < 2; ++ct)
#pragma unroll
          for (int q = 0; q < 4; ++q) { const int c = 64 * chh + 32 * ct + 8 * q + 4 * h;
              const f32x4 gw = *(const f32x4*)(gnw + c); const u32x2 uu = *(const u32x2*)(GU + gro + c);
              const float v0 = bflo(uu.x) * (acc[ct][4 * q] * gw.x + bt), v1 = bfhi(uu.x) * (acc[ct][4 * q + 1] * gw.y + bt), v2 = bflo(uu.y) * (acc[ct][4 * q + 2] * gw.z + bt), v3 = bfhi(uu.y) * (acc[ct][4 * q + 3] * gw.w + bt);
              u32x2 pk; pk.x = cvtpk(v0, v1); pk.y = cvtpk(v2, v3); *(u32x2*)(MIX + mro + c) = pk; } }
    __syncthreads();
}

constexpr int AK_STR = 144, AV_STR = 320, AK_BYTES = 64 * AK_STR, AV_BYTES = 64 * AV_STR, AKB = 0, AVB = 2 * AK_BYTES, AWSF = AVB + 2 * AV_BYTES, AQ_OFF = AWSF + 2048, AQ_WAVE = 32 * AK_STR;
constexpr float ATT_THR = 8.f;
DI void attn_unit(const Frame& F, const Params& P, const bf16_t* Qb  , const bf16_t* Kb, const bf16_t* Vb, int Lk, bf16_t* Ob  , int hd) {
    int l_tid0 = F.tid; asm volatile("" : "+v"(l_tid0));
    const int tid = l_tid0, lane = tid & 63, wid = F.wave, r = lane & 31, h = lane >> 5, g16 = (lane >> 4) & 1, q4 = (lane & 15) >> 2, p4 = lane & 3;
    LAS unsigned char* lds = F.lds;
    LAS float* wsf = (LAS float*)(lds + AWSF) + wid * 64;
    float* scr = (float*)(P.ws + WS_ASCR) + (size_t)F.vcu * 32768 + wid * 4096;
    const int NT = Lk / 64;
    f32x16 o[4];
#pragma unroll 1
    for (int mp = 0; mp < 2; ++mp) {
        int l_tid1 = tid; asm volatile("" : "+v"(l_tid1));
        const int tid = l_tid1, lane = tid & 63, r = lane & 31, h = lane >> 5, g16 = (lane >> 4) & 1, q4 = (lane & 15) >> 2, p4 = lane & 3;
        const bf16_t* Qw = Qb + (size_t)(wid * 32 + r) * 512 + mp * 64 + 8 * h;
        LAS unsigned char* qlds = lds + AQ_OFF + wid * AQ_WAVE + r * AK_STR + h * 16;
        bf16x8 qreg[4];
#pragma unroll
        for (int ks = 0; ks < 4; ++ks) qreg[ks] = *(const bf16x8*)(Qw + 16 * ks);
        const bf16_t* Kg = Kb + mp * 64;
        const unsigned kvo = (unsigned)((tid >> 3) * 512 + (tid & 7) * 8), vvo = (unsigned)((tid >> 4) * 512 + (tid & 15) * 8);
        const int kdst = (tid >> 3) * AK_STR + (tid & 7) * 16, vdst0 = (tid >> 4) * AV_STR + (tid & 15) * 16, vdst1 = vdst0 + 32 * AV_STR;
        u32x4 k2r = {};
        { const u32x4 k0 = *(const u32x4*)(Kg + kvo), v0 = *(const u32x4*)(Vb + vvo), v1 = *(const u32x4*)(Vb + 32 * 512 + vvo);
          *(LAS u32x4*)(lds + AKB + kdst) = k0; *(LAS u32x4*)(lds + AVB + vdst0) = v0; *(LAS u32x4*)(lds + AVB + vdst1) = v1;
          if (NT > 1) { const u32x4 k1 = *(const u32x4*)(Kg + (size_t)64 * 512 + kvo); *(LAS u32x4*)(lds + AKB + AK_BYTES + kdst) = k1; }
          if (NT > 2) k2r = *(const u32x4*)(Kg + (size_t)128 * 512 + kvo); }
        __syncthreads();
#pragma unroll
        for (int e = 0; e < 4; ++e) o[e] = f32x16{};
        float mhat = 0.f, lsum = 0.f;
        f32x16 negm = f32x16{};
        bf16x8 pa00, pa01, pa10, pa11;
        f32x16 p0, p1;
        bf16x8 kf[8];
#define ATT_KLD(KBUF) do { _Pragma("unroll") for (int ks = 0; ks < 4; ++ks) { \
                kf[ks] = *(const LAS bf16x8*)(lds + (KBUF) + r * AK_STR + ks * 32 + h * 16); \
                kf[4 + ks] = *(const LAS bf16x8*)(lds + (KBUF) + (32 + r) * AK_STR + ks * 32 + h * 16); } } while (0)
#define ATT_QKM() do { __builtin_amdgcn_sched_barrier(0); \
            p0 = MFMA32(kf[0], qreg[0], negm); p1 = MFMA32(kf[4], qreg[0], negm); \
            _Pragma("unroll") for (int ks = 1; ks < 4; ++ks) { p0 = MFMA32(kf[ks], qreg[ks], p0); p1 = MFMA32(kf[4 + ks], qreg[ks], p1); } \
            asm volatile("s_nop 15\n\ts_nop 7" : "+v"(p0), "+v"(p1));      \
        } while (0)
#define ATT_MAX(RM) do { float ra_ = max3f(p0[0], p0[1], p1[0]), rb_ = max3f(p0[2], p0[3], p1[1]); ra_ = max3f(ra_, p1[2], p1[3]); \
            _Pragma("unroll") for (int i = 4; i < 16; i += 4) { ra_ = max3f(ra_, p0[i], p0[i + 1]); rb_ = max3f(rb_, p0[i + 2], p0[i + 3]); ra_ = max3f(ra_, p1[i], p1[i + 1]); rb_ = max3f(rb_, p1[i + 2], p1[i + 3]); } \
            RM = max2f(ra_, rb_); RM = xhalf_max(RM); } while (0)
#define ATT_EXP() do { float sacc = 0.f; \
            _Pragma("unroll") for (int i = 0; i < 16; ++i) { p0[i] = __builtin_amdgcn_exp2f(p0[i]); p1[i] = __builtin_amdgcn_exp2f(p1[i]); sacc += p0[i] + p1[i]; } \
            lsum += sacc; } while (0)
#define ATT_VLD(DST, VBUF, E) do { LAS const unsigned char* ve_ = lds + (VBUF) + (4 * h + q4) * AV_STR + (16 * g16 + 4 * p4) * 2 + (E) * 64; \
            DST[0] = cat8(ldtr(ve_), ldtr(ve_ + 8 * AV_STR)); DST[1] = cat8(ldtr(ve_ + 16 * AV_STR), ldtr(ve_ + 24 * AV_STR)); \
            DST[2] = cat8(ldtr(ve_ + 32 * AV_STR), ldtr(ve_ + 40 * AV_STR)); DST[3] = cat8(ldtr(ve_ + 48 * AV_STR), ldtr(ve_ + 56 * AV_STR)); } while (0)
#define ATT_PV(SRC, E) do { o[E] = MFMA32(pa00, SRC[0], o[E]); o[E] = MFMA32(pa01, SRC[1], o[E]); o[E] = MFMA32(pa10, SRC[2], o[E]); o[E] = MFMA32(pa11, SRC[3], o[E]); } while (0)
        ATT_KLD(AKB); ATT_QKM();
        { float rm; ATT_MAX(rm); mhat = rm;
#pragma unroll
          for (int i = 0; i < 16; ++i) { p0[i] -= rm; p1[i] -= rm; negm[i] = -mhat; }
          ATT_EXP(); pa00 = pack8(p0, 0); pa01 = pack8(p0, 1); pa10 = pack8(p1, 0); pa11 = pack8(p1, 1); }
        if (NT > 1) ATT_KLD(AKB + AK_BYTES);
        __syncthreads();
        if (NT > 2) *(LAS u32x4*)(lds + AKB + kdst) = k2r;
        __syncthreads();
#pragma unroll 1
        for (int t = 0; t < NT; ++t) {
            const int vcur = AVB + (t & 1) * AV_BYTES, vnxt = AVB + AV_BYTES - (t & 1) * AV_BYTES, knxt = AKB + AK_BYTES - (t & 1) * AK_BYTES, kfar = AKB + (t & 1) * AK_BYTES;
            const bool m1 = (t + 1 < NT), m2 = (t + 2 < NT), m3 = (t + 3 < NT);
            u32x4 kr = {}, v0 = {}, v1 = {};
            if (m3) kr = *(const u32x4*)(Kg + (size_t)(t + 3) * 64 * 512 + kvo);
            if (m1) { const size_t go = (size_t)(t + 1) * 64 * 512; v0 = *(const u32x4*)(Vb + go + vvo); v1 = *(const u32x4*)(Vb + go + 32 * 512 + vvo); }
            bf16x8 va_[4], vb_[4]; bool resc = false;
            if (m1) {
                ATT_QKM();
                float rm; ATT_MAX(rm);
                if (__any(rm > ATT_THR)) {
                    const float dl = fmaxf(rm, 0.f); mhat += dl;
#pragma unroll
                    for (int i = 0; i < 16; ++i) { p0[i] -= dl; p1[i] -= dl; negm[i] = -mhat; }
                    const float f = __builtin_amdgcn_exp2f(-dl); lsum *= f; if (h == 0) wsf[r] = f; resc = true; }
                ATT_VLD(va_, vcur, 0); ATT_VLD(vb_, vcur, 1);
                __builtin_amdgcn_s_setprio(1);
                ATT_PV(va_, 0); ATT_VLD(va_, vcur, 2); ATT_PV(vb_, 1); ATT_VLD(vb_, vcur, 3); ATT_PV(va_, 2); ATT_PV(vb_, 3);
                ATT_EXP();
                bf16x8 n00 = pack8(p0, 0), n01 = pack8(p0, 1), n10 = pack8(p1, 0), n11 = pack8(p1, 1);
                asm volatile("" : "+v"(n00), "+v"(n01), "+v"(n10), "+v"(n11)); __builtin_amdgcn_s_setprio(0);
#pragma unroll
                for (int i = 0; i < 16; ++i) { __builtin_amdgcn_sched_group_barrier(0x008, 1, 0); __builtin_amdgcn_sched_group_barrier(0x002, 6, 0); }
                if (resc) {
#pragma unroll
                    for (int reg = 0; reg < 16; ++reg) { const float fr_ = wsf[crow(reg, h)];
#pragma unroll
                        for (int e = 0; e < 4; ++e) o[e][reg] *= fr_; } }
                pa00 = n00; pa01 = n01; pa10 = n10; pa11 = n11;
            } else {
                ATT_VLD(va_, vcur, 0); ATT_VLD(vb_, vcur, 1); ATT_PV(va_, 0); ATT_VLD(va_, vcur, 2); ATT_PV(vb_, 1); ATT_VLD(vb_, vcur, 3); ATT_PV(va_, 2); ATT_PV(vb_, 3);
            }
            if (m2) ATT_KLD(kfar);
            if (m3) *(LAS u32x4*)(lds + knxt + kdst) = kr;
            if (m1) { *(LAS u32x4*)(lds + vnxt + vdst0) = v0; *(LAS u32x4*)(lds + vnxt + vdst1) = v1; }
            __syncthreads();
        }
#undef ATT_KLD
#undef ATT_QKM
#undef ATT_MAX
#undef ATT_EXP
#undef ATT_VLD
#undef ATT_PV
        lsum = xhalf_sum(lsum);
        { int l_lane = lane; asm volatile("" : "+v"(l_lane));
        const int lane = l_lane, r = lane & 31, h = lane >> 5;
        if (h == 0) wsf[32 + r] = 1.f / lsum;
        if (mp == 0) {
#pragma unroll
            for (int reg = 0; reg < 16; ++reg) { const float li = wsf[32 + crow(reg, h)];
#pragma unroll
                for (int e = 0; e < 4; ++e) scr[(e * 16 + reg) * 64 + lane] = o[e][reg] * li; }
        } else {
            const float* sw = P.in[I_SUBLN];
            const float lam = *(const float*)(P.ws + WS_LAM);
            float swv[4];
#pragma unroll
            for (int e = 0; e < 4; ++e) swv[e] = sw[32 * e + r];
#pragma unroll
            for (int reg = 0; reg < 16; ++reg) { const float li = wsf[32 + crow(reg, h)];
                float v[4], ss = 0.f;
#pragma unroll
                for (int e = 0; e < 4; ++e) { v[e] = scr[(e * 16 + reg) * 64 + lane] - lam * (o[e][reg] * li); ss += v[e] * v[e]; }
#pragma unroll
                for (int of = 1; of < 32; of <<= 1) ss += __shfl_xor(ss, of);
                const float rstd = rsqrtf(ss * (1.f / 128.f) + EPS) * (1.f - LAM_INIT);
                bf16_t* op = Ob + (size_t)(wid * 32 + crow(reg, h)) * D + hd * 128 + r;
#pragma unroll
                for (int e = 0; e < 4; ++e) op[32 * e] = (bf16_t)(cvtpk(v[e] * rstd * swv[e], 0.f) & 0xffffu); }
        }
        }
        __syncthreads();
    }
}

DI void phase_mix0(const Frame& F, const Params& P) {
    unsigned char* ws = P.ws;
    if (F.G == 256) { if (F.vcu >= 64) for (int it = F.vcu - 64; it < (T_ALL / 128) * 4; it += 192) gmlp_item(F, P, it >> 2, it & 3); }
    else for (int it = F.vcu; it < (T_ALL / 128) * 4; it += F.G) gmlp_item(F, P, it >> 2, it & 3);
    const bf16_t* Q = (const bf16_t*)(ws + WS_Q); bf16_t* MIX = (bf16_t*)(ws + WS_MIX);
#pragma unroll 1
    for (int u = F.vcu; u < 512 + 64; u += F.G) {
        const bool smp = u < 512; const int uc = u - 512;
        const int hd = smp ? ((u >> 4) & 3) : (uc & 3), b = u >> 6;
        const size_t qrow = smp ? (size_t)T_CTX + (size_t)b * SEQ_S + (u & 15) * 256 : (size_t)(uc >> 2) * 256;
        const bf16_t* Kb = smp ? (const bf16_t*)(ws + WS_KS) + (size_t)b * LKS * 512 : (const bf16_t*)(ws + WS_KC) + qrow * 512;
        const bf16_t* Vb = smp ? (const bf16_t*)(ws + WS_VS) + (size_t)b * LKS * 512 : (const bf16_t*)(ws + WS_VC) + qrow * 512;
        attn_unit(F, P, Q + qrow * 512 + hd * 128, Kb + hd * 128, Vb + hd * 128, smp ? LKS : 256, MIX + qrow * D, hd);
    }
}

constexpr int MK_STR = 528, MV_STR = 192;
constexpr int ML_KT = 0, ML_VT = 128 * MK_STR, ML_VW = ML_VT + 128 * MV_STR, ML_CT = ML_VW + 128 * MV_STR, ML_NB = ML_CT + 64 * MK_STR, ML_UV = ML_NB + 512, ML_MV = ML_UV + 512, ML_WI = ML_MV + 512,
              ML_CL = ML_WI + 512, ML_WSB = ML_CL + 512, ML_DEN = ML_WSB + 256, ML_QN = ML_DEN + 1024, ML_NF = ML_QN + 1024, ML_ZR = ML_NF + 1024, ML_END = ML_ZR + 512;
static_assert(ML_END <= MISC_OFF, "mLSTM LDS map");
template <int CTRL, int ROWMASK> DI float dpp_id(float idv, float src) { return __int_as_float(__builtin_amdgcn_update_dpp(__float_as_int(idv), __float_as_int(src), CTRL, ROWMASK, 0xf, false)); }
DI float scan_sum(float v, int lane) {
    v += dpp_id<0x111, 0xf>(0.f, v); v += dpp_id<0x112, 0xf>(0.f, v); v += dpp_id<0x114, 0xf>(0.f, v); v += dpp_id<0x118, 0xf>(0.f, v);
    v += dpp_id<0x142, 0xa>(0.f, v);
    v += dpp_id<0x143, 0xc>(0.f, v);
    return v;
}
DI float scan_max(float v, int lane) {
    const float ninf = -__builtin_inff();
    v = fmaxf(v, dpp_id<0x111, 0xf>(ninf, v)); v = fmaxf(v, dpp_id<0x112, 0xf>(ninf, v)); v = fmaxf(v, dpp_id<0x114, 0xf>(ninf, v)); v = fmaxf(v, dpp_id<0x118, 0xf>(ninf, v));
    v = fmaxf(v, dpp_id<0x142, 0xa>(ninf, v));
    v = fmaxf(v, dpp_id<0x143, 0xc>(ninf, v));
    return v;
}
template <int TB> DI void mlstm_main(LAS unsigned char* lds, bf16x8 (&qf)[16], const bf16_t* qrow_hi  , int eh, int wid, int lane, bf16_t* hp  , int hstride  ) {
    const int r = lane & 31, h = lane >> 5, g16 = (lane >> 4) & 1, q4 = (lane & 15) >> 2, p4 = lane & 3;
    LAS float* UV = (LAS float*)(lds + ML_UV); LAS float* MV = (LAS float*)(lds + ML_MV); LAS float* WI = (LAS float*)(lds + ML_WI); LAS float* CL = (LAS float*)(lds + ML_CL);
    LAS float* DEN = (LAS float*)(lds + ML_DEN) + wid * 32; LAS float* QN = (LAS float*)(lds + ML_QN) + wid * 32;
    const bf16x8 zero8 = {0, 0, 0, 0, 0, 0, 0, 0};
#pragma unroll
    for (int ks = 8; ks < 16; ++ks) qf[ks] = *(const bf16x8*)(qrow_hi + 16 * (ks - 8));
    f32x16 sT[TB + 1], ni = f32x16{}, qn = f32x16{};
#pragma unroll
    for (int st = 0; st <= TB; ++st) sT[st] = f32x16{};
    LAS const unsigned char* kb = lds + ML_KT + r * MK_STR + h * 16;
    LAS const unsigned char* cb = lds + ML_CT + (32 * eh + r) * MK_STR + h * 16;
    LAS const unsigned char* nb = lds + ((r == 0) ? ML_NB : ML_ZR) + h * 16;
    const float Mt = MV[32 * TB + r]; float rs = 0.f;
#define ML_SMMA(ST) do { _Pragma("unroll") for (int ks = 0; ks < 16; ++ks) { const bf16x8 kf = *(const LAS bf16x8*)(kb + (ST) * 32 * MK_STR + ks * 32); sT[ST] = MFMA32(kf, qf[ks], sT[ST]); } } while (0)
#define ML_PBLK(ST) do { _Pragma("unroll") for (int g = 0; g < 4; ++g) { \
            const f32x4 u4 = *(const LAS f32x4*)(UV + 32 * (ST) + 8 * g + 4 * h); \
            _Pragma("unroll") for (int i = 0; i < 4; ++i) { \
                float v = sT[ST][4 * g + i] * __builtin_amdgcn_exp2f(fminf(u4[i] - Mt, 0.f)); \
                if ((ST) == TB) v = (8 * g + 4 * h + i <= r) ? v : 0.f; \
                sT[ST][4 * g + i] = v; rs += v; } } } while (0)
    __builtin_amdgcn_s_setprio(1);
    ML_SMMA(0);
    __builtin_amdgcn_sched_barrier(0);
#pragma unroll
    for (int st = 1; st <= TB; ++st) {
        ML_SMMA(st); ML_PBLK(st - 1);
#pragma unroll
        for (int i = 0; i < 16; ++i) { __builtin_amdgcn_sched_group_barrier(0x008, 1, 0); __builtin_amdgcn_sched_group_barrier(0x002, 7, 0); }
        __builtin_amdgcn_sched_barrier(0);
    }
#pragma unroll
    for (int ks = 0; ks < 16; ++ks) {
        const bf16x8 cf = *(const LAS bf16x8*)(cb + ks * 32);
        ni = MFMA32(qf[ks], cf, ni);
        const bf16x8 nf = *(const LAS bf16x8*)(nb + ks * 32);
        qn = MFMA32(qf[ks], nf, qn);
    }
    ML_PBLK(TB);
#pragma unroll
    for (int i = 0; i < 32; ++i) { __builtin_amdgcn_sched_group_barrier(0x008, 1, 0); __builtin_amdgcn_sched_group_barrier(0x002, 4, 0); }
#undef ML_SMMA
#undef ML_PBLK
    __builtin_amdgcn_sched_barrier(0);
    rs = xhalf_sum(rs);
    if (h == 0) DEN[r] = rs;
    if (r == 0) {
#pragma unroll
        for (int g = 0; g < 4; ++g) { f32x4 t4 = {qn[4 * g], qn[4 * g + 1], qn[4 * g + 2], qn[4 * g + 3]}; *(LAS f32x4*)(QN + 8 * g + 4 * h) = t4; } }
    f32x16 nA = f32x16{};
    LAS const unsigned char* vb = lds + ML_VT + (4 * h + q4) * MV_STR + (32 * eh + 16 * g16 + 4 * p4) * 2;
#pragma unroll
    for (int st = 0; st <= TB; ++st) {
#pragma unroll
        for (int s2 = 0; s2 < 2; ++s2) { LAS const unsigned char* vp = vb + (32 * st + 16 * s2) * MV_STR;
            nA = MFMA32(pack8(sT[st], s2), cat8(ldtr(vp), ldtr(vp + 8 * MV_STR)), nA); } }
    __builtin_amdgcn_s_setprio(0);
    __builtin_amdgcn_sched_barrier(0);
    bf16_t* hl = hp + (long)hstride * (4 * h) + r;
#pragma unroll
    for (int g = 0; g < 4; ++g) {
        const f32x4 wi4 = *(const LAS f32x4*)(WI + 32 * TB + 8 * g + 4 * h), cl4 = *(const LAS f32x4*)(CL + 32 * TB + 8 * g + 4 * h);
        const f32x4 de4 = *(const LAS f32x4*)(DEN + 8 * g + 4 * h), qn4 = *(const LAS f32x4*)(QN + 8 * g + 4 * h);
#pragma unroll
        for (int i = 0; i < 4; ++i) {
            const float den = de4[i] + wi4[i] * qn4[i];
            const float hv = (nA[4 * g + i] + wi4[i] * ni[4 * g + i]) * __builtin_amdgcn_rcpf(fmaxf(fabsf(den), cl4[i]));
            hl[(long)hstride * (8 * g + i)] = (bf16_t)(cvtpk(hv, 0.f) & 0xffffu); }
        __builtin_amdgcn_sched_barrier(0); }
}
DI void mlstm_item(const Frame& F, const Params& P, int R0, int L, int sidx  , bool ctx, int hd, int dir, int sl) {
    unsigned char* ws = P.ws;
    const int wid = F.wave, tb = (wid < 4) ? wid : 7 - wid, eh = wid >> 2;
    LAS unsigned char* lds = F.lds;
    LAS float* UV = (LAS float*)(lds + ML_UV); LAS float* MV = (LAS float*)(lds + ML_MV); LAS float* WI = (LAS float*)(lds + ML_WI); LAS float* CL = (LAS float*)(lds + ML_CL);
    LAS bf16_t* WSB = (LAS bf16_t*)(lds + ML_WSB); LAS bf16_t* NB = (LAS bf16_t*)(lds + ML_NB);
    LAS float* DEN = (LAS float*)(lds + ML_DEN) + wid * 32; LAS float* QN = (LAS float*)(lds + ML_QN) + wid * 32; LAS float* NF = (LAS float*)(lds + ML_NF);
    const bf16_t* Q1 = (const bf16_t*)(ws + WS_Q1); const bf16_t* K1 = (const bf16_t*)(ws + WS_K1); const bf16_t* V1 = (const bf16_t*)(ws + WS_V1);
    const float* GATES = (const float*)(ws + WS_GATES);
    bf16_t* HO = (bf16_t*)(ws + (dir ? WS_HB : WS_HF));
    const int nc = L / 128;
    f32x16 Cacc[2]; float m_prev = 0.f;
    {
        int l_tid0 = F.tid; asm volatile("" : "+v"(l_tid0));
        const int tid = l_tid0, lane = tid & 63, r = lane & 31, h = lane >> 5;
#pragma unroll
        for (int dt = 0; dt < 2; ++dt) Cacc[dt] = f32x16{};
        if (!ctx) {
            const size_t sbase = ((size_t)(sidx * 2 + dir) * 4 + hd);
            const float* C0 = P.in[I_SC] + sbase * 65536;
#pragma unroll
            for (int dt = 0; dt < 2; ++dt)
#pragma unroll
                for (int reg = 0; reg < 16; ++reg) { const int d = 64 * tb + 32 * dt + crow(reg, h); Cacc[dt][reg] = C0[(size_t)d * 256 + 64 * sl + 32 * eh + r]; }
            m_prev = P.in[I_SM][sbase];
        }
#pragma unroll
        for (int dt = 0; dt < 2; ++dt)
#pragma unroll
            for (int g = 0; g < 4; ++g) { u32x2 pk; pk.x = cvtpk(Cacc[dt][4 * g], Cacc[dt][4 * g + 1]); pk.y = cvtpk(Cacc[dt][4 * g + 2], Cacc[dt][4 * g + 3]);
                *(LAS u32x2*)(lds + ML_CT + (32 * eh + r) * MK_STR + (64 * tb + 32 * dt + 8 * g + 4 * h) * 2) = pk; }
        if (tid < 128) *(LAS unsigned*)(lds + ML_ZR + tid * 4) = 0u;
        if (tid < 256) { const float nv = ctx ? 0.f : P.in[I_SN][((size_t)(sidx * 2 + dir) * 4 + hd) * 256 + tid]; NF[tid] = nv; NB[tid] = (bf16_t)(cvtpk(nv, 0.f) & 0xffffu); }
    }
    const int gi = dir ? 2 : 0;
    const bf16x8 zero8 = {0, 0, 0, 0, 0, 0, 0, 0};
    bf16x8 qf[16];
    float decay = 1.f, m_new = 0.f;
#pragma unroll 1
    for (int c = -1; c < nc; ++c) {
        int l_tid = F.tid; asm volatile("" : "+v"(l_tid));
        const int tid = l_tid, lane = tid & 63, r = lane & 31, h = lane >> 5, g16 = (lane >> 4) & 1, q4 = (lane & 15) >> 2, p4 = lane & 3;
        const int ci = dir ? nc - 1 - c : c, base = R0 + ci * 128;
        const bool more = (c + 1 < nc);
        const int nbase = R0 + (dir ? nc - 2 - c : c + 1) * 128;
#define ROWOF(b_, i) ((b_) + (dir ? 127 - (i) : (i)))
        f32x16 nd;
        if (c >= 0) {
            const int trow = 32 * tb + r;
            const bf16_t* qrow_hi = Q1 + (size_t)ROWOF(base, trow) * D + hd * 256 + 8 * h + 128;
            const int hstride = dir ? -D : D;
            bf16_t* hp = HO + (size_t)(base + (dir ? 127 - 32 * tb : 32 * tb)) * D + hd * 256 + sl * 64 + 32 * eh;
            switch (tb) {
                case 0: mlstm_main<0>(lds, qf, qrow_hi, eh, wid, lane, hp, hstride); break;
                case 1: mlstm_main<1>(lds, qf, qrow_hi, eh, wid, lane, hp, hstride); break;
                case 2: mlstm_main<2>(lds, qf, qrow_hi, eh, wid, lane, hp, hstride); break;
                default: mlstm_main<3>(lds, qf, qrow_hi, eh, wid, lane, hp, hstride); break;
            }
        }
        float li0 = 0.f, lf0 = 0.f, li1 = 0.f, lf1 = 0.f;
        __builtin_amdgcn_sched_barrier(0);
        if (more) {
            const bf16_t* qrow = Q1 + (size_t)ROWOF(nbase, 32 * tb + r) * D + hd * 256 + 8 * h;
#pragma unroll
            for (int ks = 0; ks < 8; ++ks) qf[ks] = *(const bf16x8*)(qrow + 16 * ks);
            const float* g0 = GATES + (size_t)ROWOF(nbase, lane) * 16 + gi * 4 + hd; const float* g1 = GATES + (size_t)ROWOF(nbase, lane + 64) * 16 + gi * 4 + hd;
            li0 = g0[0]; lf0 = g0[4]; li1 = g1[0]; lf1 = g1[4];
        }
        if (c >= 0) {
#pragma unroll
            for (int dt = 0; dt < 2; ++dt) Cacc[dt] = Cacc[dt] * decay;
            nd = f32x16{};
#pragma unroll 2
            for (int ks = 0; ks < 8; ++ks) {
                LAS const unsigned char* wp = lds + ML_VW + (16 * ks + 8 * h + q4) * MV_STR + (32 * eh + 16 * g16 + 4 * p4) * 2;
                const bf16x8 bw = cat8(ldtr(wp), ldtr(wp + 4 * MV_STR));
                const bf16x8 wsv = *(const LAS bf16x8*)(lds + ML_WSB + ks * 32 + h * 16);
#pragma unroll
                for (int dt = 0; dt < 2; ++dt) {
                    LAS const unsigned char* kp = lds + ML_KT + (16 * ks + 8 * h + q4) * MK_STR + (64 * tb + 32 * dt + 16 * g16 + 4 * p4) * 2;
                    const bf16x8 ak = cat8(ldtr(kp), ldtr(kp + 4 * MK_STR));
                    Cacc[dt] = MFMA32(ak, bw, Cacc[dt]);
                    if (eh == 0) nd = MFMA32((r == dt) ? wsv : zero8, ak, nd);
                }
                __builtin_amdgcn_sched_barrier(0);
            }
        }
        __syncthreads();
        if (c >= 0) {
#pragma unroll
            for (int dt = 0; dt < 2; ++dt)
#pragma unroll
                for (int g = 0; g < 4; ++g) { u32x2 pk; pk.x = cvtpk(Cacc[dt][4 * g], Cacc[dt][4 * g + 1]); pk.y = cvtpk(Cacc[dt][4 * g + 2], Cacc[dt][4 * g + 3]);
                    *(LAS u32x2*)(lds + ML_CT + (32 * eh + r) * MK_STR + (64 * tb + 32 * dt + 8 * g + 4 * h) * 2) = pk; }
            if (eh == 0 && h == 0) {
#pragma unroll
                for (int dt = 0; dt < 2; ++dt) { const int d = 64 * tb + 32 * dt + r; const float nv = decay * NF[d] + nd[dt]; NF[d] = nv; NB[d] = (bf16_t)(cvtpk(nv, 0.f) & 0xffffu); }
            }
            m_prev = m_new;
        }
        if (more) {
            u32x4 kreg[8], vreg[2];
#pragma unroll
            for (int j = 0; j < 8; ++j) { const int idx = tid + 512 * j, i = idx >> 5, ch = idx & 31; kreg[j] = *(const u32x4*)(K1 + (size_t)ROWOF(nbase, i) * D + hd * 256 + ch * 8); }
#pragma unroll
            for (int j = 0; j < 2; ++j) { const int i = (tid >> 3) + 64 * j, ch = tid & 7; vreg[j] = *(const u32x4*)(V1 + (size_t)ROWOF(nbase, i) * D + hd * 256 + sl * 64 + ch * 8); }
            __builtin_amdgcn_sched_barrier(0);
            const int i0 = lane, i1 = lane + 64;
            const float b0 = scan_sum(lf0, lane); const float tot = __int_as_float(__builtin_amdgcn_readlane(__float_as_int(b0), 63)); const float b1 = scan_sum(lf1, lane) + tot;
            const float u0 = li0 - b0, u1 = li1 - b1;
            const float cm0 = scan_max(u0, lane); const float top = __int_as_float(__builtin_amdgcn_readlane(__float_as_int(cm0), 63)); const float cm1 = fmaxf(scan_max(u1, lane), top);
            const float M0 = fmaxf(m_prev, cm0), M1 = fmaxf(m_prev, cm1);
            const float b_end = __int_as_float(__builtin_amdgcn_readlane(__float_as_int(b1), 63)), Mend = __int_as_float(__builtin_amdgcn_readlane(__float_as_int(M1), 63));
            const float ws0 = __expf(u0 - Mend), ws1 = __expf(u1 - Mend);
            decay = __expf(m_prev - Mend); m_new = b_end + Mend;
            if (wid == 0) { UV[i0] = u0 * 1.4426950408889634f; UV[i1] = u1 * 1.4426950408889634f; MV[i0] = M0 * 1.4426950408889634f; MV[i1] = M1 * 1.4426950408889634f; WI[i0] = __expf(m_prev - M0); WI[i1] = __expf(m_prev - M1);
                CL[i0] = __expf(-(b0 + M0)); CL[i1] = __expf(-(b1 + M1)); WSB[i0] = (bf16_t)(cvtpk(ws0, 0.f) & 0xffffu); WSB[i1] = (bf16_t)(cvtpk(ws1, 0.f) & 0xffffu); }
#pragma unroll
            for (int j = 0; j < 8; ++j) { const int idx = tid + 512 * j, i = idx >> 5, ch = idx & 31; *(LAS u32x4*)(lds + ML_KT + i * MK_STR + ch * 16) = kreg[j]; }
#pragma unroll
            for (int j = 0; j < 2; ++j) { const int i = (tid >> 3) + 64 * j, ch = tid & 7;
                const float wv = __shfl(j ? ws1 : ws0, (tid >> 3) & 63);
                float f[8]; unpack8(vreg[j], f);
                u32x4 w; w.x = cvtpk(f[0] * wv, f[1] * wv); w.y = cvtpk(f[2] * wv, f[3] * wv); w.z = cvtpk(f[4] * wv, f[5] * wv); w.w = cvtpk(f[6] * wv, f[7] * wv);
                *(LAS u32x4*)(lds + ML_VT + i * MV_STR + ch * 16) = vreg[j]; *(LAS u32x4*)(lds + ML_VW + i * MV_STR + ch * 16) = w; }
        }
        __syncthreads();
#undef ROWOF
    }
    if (ctx) {
        int l_tid = F.tid; asm volatile("" : "+v"(l_tid));
        const int tid = l_tid, lane = tid & 63, r = lane & 31, h = lane >> 5;
        const size_t sbase = ((size_t)(sidx * 2 + dir) * 4 + hd);
        float* Co = P.out + OUT_SC + sbase * 65536;
#pragma unroll
        for (int dt = 0; dt < 2; ++dt)
#pragma unroll
            for (int reg = 0; reg < 16; ++reg) { const int d = 64 * tb + 32 * dt + crow(reg, h);
                Co[(size_t)d * 256 + 64 * sl + 32 * eh + r] = Cacc[dt][reg];
                if (sl == 0 && eh == 0 && r == 0) P.out[OUT_SN + sbase * 256 + d] = NF[d]; }
        if (sl == 0 && tid == 0) P.out[OUT_SM + sbase] = m_prev;
    }
    __syncthreads();
}
DI void phase_mlstm(const Frame& F, const Params& P) {
#pragma unroll 1
    for (int it = F.vcu; it < 768; it += F.G) {
        const bool ctx = it >= 256; const int j = ctx ? it - 256 : it;
        const int sl = j & 3, dir = (j >> 2) & 1, hd = (j >> 3) & 3, sq = j >> 5;
        mlstm_item(F, P, ctx ? sq * SEQ_C : T_CTX + sq * SEQ_S, ctx ? SEQ_C : SEQ_S, sq, ctx, hd, dir, sl);
    }
}

constexpr int UP_EARLY = 2;
constexpr int NPHASE = 18;
__global__ void __launch_bounds__(512, 2) hybrid_fwd(Params P) {
    extern __shared__ __attribute__((aligned(16))) unsigned char lds_raw[];
    Frame F;
    F.lds = (LAS unsigned char*)lds_raw;
    F.wave = __builtin_amdgcn_readfirstlane((int)threadIdx.x >> 6); F.lane = hw_lane(); F.tid = F.wave * 64 + F.lane;
    F.G = gridDim.x; { const int bx = blockIdx.x; F.vcu = (F.G % 8 == 0) ? (bx % 8) * (F.G / 8) + bx / 8 : bx; }
    F.gw = F.vcu * 8 + F.wave; F.NGW = F.G * 8;
    unsigned char* ws = P.ws;
    volatile LAS unsigned* MISC = (volatile LAS unsigned*)(F.lds + MISC_OFF);
    if (F.tid < 64) MISC[F.tid] = 0u;
    __syncthreads();
#if MK_PER_PHASE
#define GRID_BAR() do { } while (0)
#else
    if (P.never) cg::this_grid().sync();
    XcdBarrier bar = xcd_barrier_post((unsigned*)(ws + WS_BAR), MISC + 8, F.wave);
#define GRID_BAR() xcd_barrier(bar)
#endif
    const int lo = P.ph_lo, hi = P.ph_hi;
#ifndef PH_MASK
#define PH_MASK 0x3ffff
#endif
#define IN(k) (((PH_MASK >> (k)) & 1) && lo <= (k) && (k) < hi)
#define SEAM(k) do { if (IN(k) && IN((k) + 1)) GRID_BAR(); { F.lane = hw_lane(); F.tid = F.wave * 64 + F.lane; } } while (0)
    bf16_t* XR = (bf16_t*)((unsigned char*)P.out + 72 * MiB);
    bf16_t* X4 = (bf16_t*)(ws + WS_S5);
    const float* MOD0 = (const float*)(ws + WS_MOD); const float* MOD1 = MOD0 + 9 * 6144;
    bf16_t* H = (bf16_t*)(ws + WS_H);

    const float* BIAS = (const float*)(ws + WS_BIAS);
    float* RSQA = (float*)(ws + WS_RSQA); float* RSQB = (float*)(ws + WS_RSQB); float* RSQC = (float*)(ws + WS_RSQC);
    const bf16_t* UB = (const bf16_t*)(ws + WS_UBUF);

    const bool ovl = (F.G == 256) && !MK_PER_PHASE;
    if (IN(0)) { p0_prologue(F, P);
#if defined(PROBE_DUP) && (PROBE_DUP & 1)
        GRID_BAR(); p0_prologue(F, P);
#endif
    }
    SEAM(0);
    if (IN(1)) { modulate_rows(F, P.in[I_XP], P.in[I_XS], P.in[I_N1W], MOD0, 0, 1024, H);
#if defined(PROBE_DUP) && (PROBE_DUP & 2)
        GRID_BAR(); modulate_rows(F, P.in[I_XP], P.in[I_XS], P.in[I_N1W], MOD0, 0, 1024, H);
#endif
    }
    SEAM(1);
    if (IN(2)) {
        pg8::PlainOrder S; S.init(H, (const bf16_t*)(ws + WS_WIN0), D, D, T_ALL, NIN0, F.G, (int)blockIdx.x);
        EpiIn0 E{(bf16_t*)(ws + WS_Q), (bf16_t*)(ws + WS_KS), (bf16_t*)(ws + WS_VS), (bf16_t*)(ws + WS_KC), (bf16_t*)(ws + WS_VC), (bf16_t*)(ws + WS_GU), (bf16_t*)(ws + WS_GV),
                 P.out + OUT_CK, P.out + OUT_CV, (float*)(ws + WS_ROWSQ), (const float*)(ws + WS_ROPE)};
        pg8::gemm_phase(F.lds, S, E, D, D, F.tid);
        if (F.G == 256) { if ((int)blockIdx.x >= 160) { F.lane = hw_lane(); F.tid = F.wave * 64 + F.lane; bias_gemv(F, P, (int)blockIdx.x - 160, 96); } }
        else { F.lane = hw_lane(); F.tid = F.wave * 64 + F.lane; bias_gemv(F, P, (int)blockIdx.x, F.G); }
#if defined(PROBE_GEMM) && ((PROBE_GEMM >> 2) & 1)
        { GRID_BAR(); EpiNull EN{(float*)(ws + WS_LAM) + 8}; pg8::gemm_phase(F.lds, S, EN, D, D, F.tid); }
#endif
    }
    SEAM(2);
    if (IN(3)) { phase_mix0(F, P);
#if defined(PROBE_DUP) && (PROBE_DUP & 8)
        GRID_BAR(); phase_mix0(F, P);
#endif
    }
    SEAM(3);
    if (IN(4)) {
        const EpiRes<true, true> E{P.in[I_XP], P.in[I_XS], nullptr, XR, MOD0, 2048, H, P.in[I_N2W], MOD0, 4096, RSQA};
        { pg8::PanelOrder S; S.init((const bf16_t*)(ws + WS_MIX), (const bf16_t*)(ws + WS_WOUT0), D, D, T_ALL, F.G, (int)blockIdx.x, 0, ovl ? 2 : (1 << 20));
          pg8::gemm_phase(F.lds, S, E, D, D, F.tid); }
        if (ovl) {
            GRID_BAR(); F.lane = hw_lane(); F.tid = F.wave * 64 + F.lane;
            if ((int)blockIdx.x < 64) { F.lane = hw_lane(); F.tid = F.wave * 64 + F.lane; pg8::PanelOrder S; S.init((const bf16_t*)(ws + WS_MIX), (const bf16_t*)(ws + WS_WOUT0), D, D, T_ALL, F.G, (int)blockIdx.x, 2, 1 << 20);
                pg8::gemm_phase(F.lds, S, E, D, D, F.tid); }
            else { F.lane = hw_lane(); F.tid = F.wave * 64 + F.lane; pg8::SplitOrder S; S.init(H, (const bf16_t*)(ws + WS_WUP), D, D, 2 * DFF / 256, (int)blockIdx.x, true, UP_EARLY);
                EpiUpConv E1{(bf16_t*)(ws + WS_UBUF), (float*)(ws + WS_EDGE), P.in[I_FCW], P.in[I_FCB], (LAS float*)(F.lds + EDS_OFF), RSQA, BIAS + BIAS_UP0};
                pg8::gemm_phase(F.lds, S, E1, D, D, F.tid); }
        }
    }
    SEAM(4);
    if (IN(5)) {
        EpiUpConv E{(bf16_t*)(ws + WS_UBUF), (float*)(ws + WS_EDGE), P.in[I_FCW], P.in[I_FCB], (LAS float*)(F.lds + EDS_OFF), RSQA, BIAS + BIAS_UP0};
        if (ovl) { pg8::SplitOrder S; S.init(H, (const bf16_t*)(ws + WS_WUP), D, D, 2 * DFF / 256, (int)blockIdx.x, false, UP_EARLY);
            pg8::gemm_phase(F.lds, S, E, D, D, F.tid); }
        else { pg8::PlainOrder S; S.init(H, (const bf16_t*)(ws + WS_WUP), D, D, T_ALL, 2 * DFF, F.G, (int)blockIdx.x);
            pg8::gemm_phase(F.lds, S, E, D, D, F.tid); }
    }
    SEAM(5);
    if (IN(7)) {
        ffn_fixup_own(F, (bf16_t*)(ws + WS_UBUF), (const float*)(ws + WS_EDGE), P.in[I_FCW], (int)blockIdx.x);
        const EpiRes<true, false> E{nullptr, nullptr, XR, XR, MOD0, 5120, H, P.in[I_N1W] + D, MOD1, 1024, RSQB};
        { pg8::PanelOrder S; S.init(UB, (const bf16_t*)(ws + WS_WDOWN), DFF, DFF, T_ALL, F.G, (int)blockIdx.x, 0, ovl ? 2 : (1 << 20));
          pg8::gemm_phase(F.lds, S, E, DFF, DFF, F.tid); }
        if (ovl) {
            GRID_BAR(); F.lane = hw_lane(); F.tid = F.wave * 64 + F.lane;
            if ((int)blockIdx.x < 64) { F.lane = hw_lane(); F.tid = F.wave * 64 + F.lane; pg8::PanelOrder S; S.init(UB, (const bf16_t*)(ws + WS_WDOWN), DFF, DFF, T_ALL, F.G, (int)blockIdx.x, 2, 1 << 20);
                pg8::gemm_phase(F.lds, S, E, DFF, DFF, F.tid); }
            else { F.lane = hw_lane(); F.tid = F.wave * 64 + F.lane; pg8::SplitOrder S; S.init(H, (const bf16_t*)(ws + WS_WIN1), D, D, NIN1P / 256, (int)blockIdx.x, true, 3);
                EpiIn1 E1{(bf16_t*)(ws + WS_XM), (bf16_t*)(ws + WS_OG), (float*)(ws + WS_GATES), P.in[I_BG], RSQB, BIAS + BIAS_IN1};
                pg8::gemm_phase(F.lds, S, E1, D, D, F.tid); }
        }
    }
    SEAM(7);
    if (IN(8)) {
        EpiIn1 E{(bf16_t*)(ws + WS_XM), (bf16_t*)(ws + WS_OG), (float*)(ws + WS_GATES), P.in[I_BG], RSQB, BIAS + BIAS_IN1};
        if (ovl) { pg8::SplitOrder S; S.init(H, (const bf16_t*)(ws + WS_WIN1), D, D, NIN1P / 256, (int)blockIdx.x, false, 3);
            pg8::gemm_phase(F.lds, S, E, D, D, F.tid); }
        else { pg8::PlainOrder S; S.init(H, (const bf16_t*)(ws + WS_WIN1), D, D, T_ALL, NIN1P, F.G, (int)blockIdx.x);
            pg8::gemm_phase(F.lds, S, E, D, D, F.tid); }
    }
    SEAM(8);
    if (IN(9)) { mconv_rows(F, (const bf16_t*)(ws + WS_XM), (bf16_t*)(ws + WS_XC), P.in[I_MCW], P.in[I_MCB]);
#if defined(PROBE_DUP) && (PROBE_DUP & 0x200)
        GRID_BAR(); mconv_rows(F, (const bf16_t*)(ws + WS_XM), (bf16_t*)(ws + WS_XC), P.in[I_MCW], P.in[I_MCB]);
#endif
    }
    SEAM(9);
    if (IN(10)) {
        QkvOrder S; S.init((const bf16_t*)(ws + WS_XC), (const bf16_t*)(ws + WS_XM), (const bf16_t*)(ws + WS_WQKV1), F.G, (int)blockIdx.x);
        EpiQkv1 E{(bf16_t*)(ws + WS_Q1), (bf16_t*)(ws + WS_K1), (bf16_t*)(ws + WS_V1)};
        int kq = 256; asm volatile("" : "+s"(kq));
        pg8::gemm_phase(F.lds, S, E, D, kq, F.tid);
#if defined(PROBE_GEMM) && ((PROBE_GEMM >> 10) & 1)
        { GRID_BAR(); EpiNull EN{(float*)(ws + WS_LAM) + 8}; pg8::gemm_phase(F.lds, S, EN, D, kq, F.tid); }
#endif
    }
    SEAM(10);
    if (IN(11)) { phase_mlstm(F, P);
#if defined(PROBE_DUP) && (PROBE_DUP & 0x800)
        GRID_BAR(); phase_mlstm(F, P);
#endif
    }
    SEAM(11);
    if (IN(12)) { p16_weights(F, P); mpost_rows(F, (const bf16_t*)(ws + WS_HF), (const bf16_t*)(ws + WS_HB), (const bf16_t*)(ws + WS_OG), (const bf16_t*)(ws + WS_XC), P.in[I_HNW], P.in[I_SKIP], (bf16_t*)(ws + WS_Y1));
#if defined(PROBE_DUP) && (PROBE_DUP & 0x1000)
        GRID_BAR(); p16_weights(F, P); mpost_rows(F, (const bf16_t*)(ws + WS_HF), (const bf16_t*)(ws + WS_HB), (const bf16_t*)(ws + WS_OG), (const bf16_t*)(ws + WS_XC), P.in[I_HNW], P.in[I_SKIP], (bf16_t*)(ws + WS_Y1));
#endif
    }
    SEAM(12);
    if (IN(13)) {
        const EpiRes<true, false> E{nullptr, nullptr, XR, XR, MOD1, 2048, H, P.in[I_N2W] + D, MOD1, 4096, RSQC};
        { pg8::PanelOrder S; S.init((const bf16_t*)(ws + WS_Y1), (const bf16_t*)(ws + WS_WOUT1), D, D, T_ALL, F.G, (int)blockIdx.x, 0, ovl ? 2 : (1 << 20));
          pg8::gemm_phase(F.lds, S, E, D, D, F.tid); }
        if (ovl) {
            GRID_BAR(); F.lane = hw_lane(); F.tid = F.wave * 64 + F.lane;
            if ((int)blockIdx.x < 64) { F.lane = hw_lane(); F.tid = F.wave * 64 + F.lane; pg8::PanelOrder S; S.init((const bf16_t*)(ws + WS_Y1), (const bf16_t*)(ws + WS_WOUT1), D, D, T_ALL, F.G, (int)blockIdx.x, 2, 1 << 20);
                pg8::gemm_phase(F.lds, S, E, D, D, F.tid); }
            else { F.lane = hw_lane(); F.tid = F.wave * 64 + F.lane; pg8::SplitOrder S; S.init(H, (const bf16_t*)(ws + WS_WUP1), D, D, 2 * DFF / 256, (int)blockIdx.x, true, UP_EARLY);
                EpiUpConv E1{(bf16_t*)(ws + WS_UBUF), (float*)(ws + WS_EDGE), P.in[I_FCW] + 3 * DFF, P.in[I_FCB] + DFF, (LAS float*)(F.lds + EDS_OFF), RSQC, BIAS + BIAS_UP1};
                pg8::gemm_phase(F.lds, S, E1, D, D, F.tid); }
        }
    }
    SEAM(13);
    if (IN(14)) {
        EpiUpConv E{(bf16_t*)(ws + WS_UBUF), (float*)(ws + WS_EDGE), P.in[I_FCW] + 3 * DFF, P.in[I_FCB] + DFF, (LAS float*)(F.lds + EDS_OFF), RSQC, BIAS + BIAS_UP1};
        if (ovl) { pg8::SplitOrder S; S.init(H, (const bf16_t*)(ws + WS_WUP1), D, D, 2 * DFF / 256, (int)blockIdx.x, false, UP_EARLY);
            pg8::gemm_phase(F.lds, S, E, D, D, F.tid); }
        else { pg8::PlainOrder S; S.init(H, (const bf16_t*)(ws + WS_WUP1), D, D, T_ALL, 2 * DFF, F.G, (int)blockIdx.x);
            pg8::gemm_phase(F.lds, S, E, D, D, F.tid); }
    }
    SEAM(14);
    if (IN(16)) {
        ffn_fixup_own(F, (bf16_t*)(ws + WS_UBUF), (const float*)(ws + WS_EDGE), P.in[I_FCW] + 3 * DFF, (int)blockIdx.x);
        const EpiRes<false, false> E{nullptr, nullptr, XR, X4, MOD1, 5120, nullptr, nullptr, nullptr, 0, nullptr};
        { pg8::PanelOrder S; S.init(UB, (const bf16_t*)(ws + WS_WDOWN1), DFF, DFF, T_ALL, F.G, (int)blockIdx.x, 0, 2);
          pg8::gemm_phase(F.lds, S, E, DFF, DFF, F.tid); }
        GRID_BAR(); F.lane = hw_lane(); F.tid = F.wave * 64 + F.lane;
        if ((int)blockIdx.x < 64 || !ovl) { F.lane = hw_lane(); F.tid = F.wave * 64 + F.lane; pg8::PanelOrder S; S.init(UB, (const bf16_t*)(ws + WS_WDOWN1), DFF, DFF, T_ALL, F.G, (int)blockIdx.x, 2, 1 << 20);
          pg8::gemm_phase(F.lds, S, E, DFF, DFF, F.tid); }
        else { F.lane = hw_lane(); F.tid = F.wave * 64 + F.lane; final_norm_rows(F, X4, P.out, P.in[I_FNW], 0, 128 * 256, ((int)blockIdx.x - 64) * 8 + F.wave, 192 * 8); }
    }
    SEAM(16);
    if (IN(17)) final_norm_rows(F, X4, P.out, P.in[I_FNW], ovl ? 128 * 256 : 0, T_ALL, F.gw, F.NGW);
#undef IN
#undef SEAM
}

extern "C" void kernel_launch(void* const* d_in, const int* in_sizes, int n_in, void* d_out, int out_size, void* d_ws, size_t ws_size, hipStream_t stream) {
    static int grid = 0;
    if (grid == 0) {
        if (n_in != 38 || ws_size < WS_END) { fprintf(stderr, "kernel_launch: expected 38 inputs and >= %zu bytes of workspace (got %d, %zu)\n", (size_t)WS_END, n_in, ws_size); grid = -1; return; }
        int dev = 0, cus = 0, per_cu = 0;
        if (hipGetDevice(&dev) != hipSuccess || hipDeviceGetAttribute(&cus, hipDeviceAttributeMultiprocessorCount, dev) != hipSuccess) { grid = -1; return; }
        if (hipFuncSetAttribute((const void*)hybrid_fwd, hipFuncAttributeMaxDynamicSharedMemorySize, LDS_BYTES) != hipSuccess) { fprintf(stderr, "kernel_launch: hipFuncSetAttribute failed\n"); grid = -1; return; }
        if (hipOccupancyMaxActiveBlocksPerMultiprocessor(&per_cu, (const void*)hybrid_fwd, 512, LDS_BYTES) != hipSuccess || per_cu < 1) { fprintf(stderr, "kernel_launch: occupancy query says %d blocks per CU\n", per_cu); per_cu = 1; }
        (void)hipGetLastError();
        grid = cus;
    }
    if (grid < 0) return;
    (void)hipMemsetAsync((char*)d_ws, 0, WS_ZERO_BYTES, stream);
    Params p{};
    for (int i = 0; i < 38; ++i) p.in[i] = (const float*)d_in[i];
    p.out = (float*)d_out; p.ws = (unsigned char*)d_ws; p.never = 0; p.pad = 0;
#if MK_PER_PHASE
    for (int ph = 0; ph < NPHASE; ++ph) { p.ph_lo = ph; p.ph_hi = ph + 1; hipLaunchKernelGGL(hybrid_fwd, dim3(grid), dim3(512), LDS_BYTES, stream, p); }
#else
    p.ph_lo = 0; p.ph_hi = NPHASE;
    void* args[] = {&p};
    hipError_t e = hipLaunchCooperativeKernel((const void*)hybrid_fwd, dim3(grid), dim3(512), args, LDS_BYTES, stream);
    if (e != hipSuccess) fprintf(stderr, "kernel_launch: cooperative launch failed: %s (grid %d)\n", hipGetErrorString(e), grid);
#endif
}
```
